# Optimizing an MI355X kernel written in HIP

```python
import math
import jax, jax.numpy as jnp
from jax import lax
import numpy as np

D_MODEL = 1024
BATCH = 1
SEQ = 16384
DEPTH = 2
DEC_BATCH = 32
DEC_SEQ = 16
PAST_LEN = 1024

CHUNK = 64
Q_BLOCK = 128
N_A = DEPTH // 2
N_B = DEPTH - N_A
EPS = 1e-6
M_EXPAND = 2
D_INNER = M_EXPAND * D_MODEL
M_HEAD_DIM = 64
M_HEADS = D_INNER // M_HEAD_DIM
M_GROUPS = 4
D_STATE = 128
M_CONV_W = 4
CONV_DIM = D_INNER + 2 * M_GROUPS * D_STATE
IN_PROJ_DIM = D_INNER + CONV_DIM + M_HEADS
HEAD_DIM = 64
N_HEADS = D_MODEL // HEAD_DIM
ATTN_SCALE = HEAD_DIM ** -0.5
FORGET_BIAS_INIT = 3.0
D_FF = 2816
F_CONV_W = 3

kernel_name = 'hybrid_ssd_fox_yoco_stream_step'


def rmsnorm(x, w):
    xf = x.astype(jnp.float32)
    y = xf * lax.rsqrt(jnp.mean(xf * xf, axis=-1, keepdims=True) + EPS)
    return (y * w.astype(jnp.float32)).astype(x.dtype)


def causal_dwconv(u, prev, w, b):
    width = w.shape[0]
    l = u.shape[1]
    full = jnp.concatenate([prev.astype(u.dtype), u], axis=1)
    out = b
    for tap in range(width):
        out = out + full[:, tap:tap + l] * w[tap]
    return out, full[:, full.shape[1] - (width - 1):]


def ssd_scan(x, dt, A, B, C, h0):
    b, l, h, p = x.shape
    g, n = B.shape[2], B.shape[3]
    r = h // g
    L = min(CHUNK, l)
    nc = l // L
    f32 = jnp.float32
    xf = x.astype(f32).reshape(b, nc, L, g, r, p)
    dtb = dt.reshape(b, nc, L, g, r)
    Bb = B.astype(f32).reshape(b, nc, L, g, n)
    Cb = C.astype(f32).reshape(b, nc, L, g, n)
    acum = jnp.cumsum(dtb * A.reshape(g, r), axis=2)
    causal = jnp.tril(jnp.ones((L, L), dtype=bool))
    seg = acum[:, :, :, None] - acum[:, :, None, :]
    decay = jnp.exp(jnp.where(causal[:, :, None, None], seg, -jnp.inf))
    cb = jnp.einsum('bctgn,bcsgn->bctsg', Cb, Bb)
    w_ts = cb[..., None] * decay * dtb[:, :, None]
    y_intra = jnp.einsum('bctsgr,bcsgrp->bctgrp', w_ts, xf)
    to_end = jnp.exp(acum[:, :, -1:] - acum) * dtb
    st = jnp.einsum('bcsgn,bcsgrp->bcgrpn', Bb, to_end[..., None] * xf)
    blk_decay = jnp.exp(acum[:, :, -1])

    def step(hc, inp):
        s_c, d_c = inp
        return hc * d_c[..., None, None] + s_c, hc

    h_last, h_in = lax.scan(step, h0.astype(f32).reshape(b, g, r, p, n),
                            (jnp.moveaxis(st, 1, 0), jnp.moveaxis(blk_decay, 1, 0)))
    h_in = jnp.moveaxis(h_in, 0, 1)
    y_inter = jnp.einsum('bctgn,bcgrpn->bctgrp', Cb, h_in) * jnp.exp(acum)[..., None]
    y = (y_intra + y_inter).reshape(b, l, h, p)
    return y.astype(x.dtype), h_last.reshape(b, h, p, n).astype(h0.dtype)


def mamba_mixer(u, ssm0, conv0, w_in, conv_w, conv_b, dt_bias, A_log, Dp, norm_w, w_out):
    b, l, _ = u.shape
    zxbcdt = u @ w_in
    z = zxbcdt[..., :D_INNER]
    xbc = zxbcdt[..., D_INNER:D_INNER + CONV_DIM]
    dt_raw = zxbcdt[..., D_INNER + CONV_DIM:]
    xbc, conv_new = causal_dwconv(xbc, conv0, conv_w, conv_b)
    xbc = jax.nn.silu(xbc)
    xs = xbc[..., :D_INNER].reshape(b, l, M_HEADS, M_HEAD_DIM)
    Bm = xbc[..., D_INNER:D_INNER + M_GROUPS * D_STATE].reshape(b, l, M_GROUPS, D_STATE)
    Cm = xbc[..., D_INNER + M_GROUPS * D_STATE:].reshape(b, l, M_GROUPS, D_STATE)
    dt = jax.nn.softplus((dt_raw + dt_bias).astype(jnp.float32))
    A = -jnp.exp(A_log.astype(jnp.float32))
    y, ssm_new = ssd_scan(xs, dt, A, Bm, Cm, ssm0)
    y = (y + Dp[:, None] * xs).reshape(b, l, D_INNER) * jax.nn.silu(z)
    gs = D_INNER // M_GROUPS
    y = rmsnorm(y.reshape(b, l, M_GROUPS, gs), norm_w.reshape(M_GROUPS, gs)).reshape(b, l, D_INNER)
    return y @ w_out, ssm_new, conv_new


def fox_attend(q, k, v, cq, ck, q_pos, k_pos):
    s = jnp.einsum('bqhd,bkhd->bhqk', q, k).astype(jnp.float32) * ATTN_SCALE
    s = s + jnp.swapaxes(cq, 1, 2)[..., :, None] - jnp.swapaxes(ck, 1, 2)[..., None, :]
    s = jnp.where(q_pos[:, None] >= k_pos[None, :], s, -jnp.inf)
    pr = jax.nn.softmax(s, axis=-1).astype(v.dtype)
    return jnp.einsum('bhqk,bkhd->bqhd', pr, v)


def fox_mixer(u, k_all, v_all, c_all, p0, w_q, w_o):
    b, l, _ = u.shape
    q = (u @ w_q).reshape(b, l, N_HEADS, HEAD_DIM)
    c_q = c_all[:, p0:]
    k_pos = jnp.arange(k_all.shape[1])
    q_pos = p0 + jnp.arange(l)
    if l % Q_BLOCK == 0:
        nq = l // Q_BLOCK
        qb = jnp.swapaxes(q.reshape(b, nq, Q_BLOCK, N_HEADS, HEAD_DIM), 0, 1)
        cqb = jnp.swapaxes(c_q.reshape(b, nq, Q_BLOCK, N_HEADS), 0, 1)
        pb = q_pos.reshape(nq, Q_BLOCK)
        o = lax.map(lambda blk: fox_attend(blk[0], k_all, v_all, blk[1], c_all, blk[2], k_pos), (qb, cqb, pb))
        o = jnp.swapaxes(o, 0, 1).reshape(b, l, N_HEADS * HEAD_DIM)
    else:
        o = fox_attend(q, k_all, v_all, c_q, c_all, q_pos, k_pos).reshape(b, l, N_HEADS * HEAD_DIM)
    return o @ w_o


def conv_ffn(u, prev, w_up, conv_w, conv_b, w_down):
    up, buf_new = causal_dwconv(u @ w_up, prev, conv_w, conv_b)
    gate = up[..., :D_FF]
    val = up[..., D_FF:]
    return (jax.nn.silu(gate) * val) @ w_down, buf_new


def trunk(x, ssm0, mconv0, fconv0, past_k, past_v, past_logf,
          norm_mix_w, norm_ffn_w, mamba_w_in, mamba_conv_w, mamba_conv_b, mamba_dt_bias,
          mamba_A_log, mamba_D, mamba_norm_w, mamba_w_out, kv_norm_w, w_k, w_v, w_f, b_f,
          attn_w_q, attn_w_o, ffn_w_up, ffn_conv_w, ffn_conv_b, ffn_w_down, final_norm_w):
    b, l, _ = x.shape
    p0 = past_k.shape[1]
    h = x
    ssm_out, mconv_out, fconv_out = [], [], []
    k_new = v_new = logf_new = None
    for i in range(DEPTH):
        if i == N_A:
            hk = rmsnorm(h, kv_norm_w)
            k_new = (hk @ w_k).reshape(b, l, N_HEADS, HEAD_DIM)
            v_new = (hk @ w_v).reshape(b, l, N_HEADS, HEAD_DIM)
            logf_new = jax.nn.log_sigmoid((hk @ w_f + b_f).astype(jnp.float32))
            k_all = jnp.concatenate([past_k.astype(k_new.dtype), k_new], axis=1)
            v_all = jnp.concatenate([past_v.astype(v_new.dtype), v_new], axis=1)
            c_all = jnp.cumsum(jnp.concatenate([past_logf.astype(jnp.float32), logf_new], axis=1), axis=1)
        u = rmsnorm(h, norm_mix_w[i])
        if i < N_A:
            mix, s_new, c_new = mamba_mixer(u, ssm0[i], mconv0[i], mamba_w_in[i], mamba_conv_w[i],
                                            mamba_conv_b[i], mamba_dt_bias[i], mamba_A_log[i],
                                            mamba_D[i], mamba_norm_w[i], mamba_w_out[i])
            ssm_out.append(s_new)
            mconv_out.append(c_new)
        else:
            j = i - N_A
            mix = fox_mixer(u, k_all, v_all, c_all, p0, attn_w_q[j], attn_w_o[j])
        h = h + mix
        f, fc_new = conv_ffn(rmsnorm(h, norm_ffn_w[i]), fconv0[i], ffn_w_up[i], ffn_conv_w[i],
                             ffn_conv_b[i], ffn_w_down[i])
        fconv_out.append(fc_new)
        h = h + f
    y = rmsnorm(h, final_norm_w)
    return (y, jnp.stack(ssm_out), jnp.stack(mconv_out), jnp.stack(fconv_out),
            k_new, v_new, logf_new.astype(past_logf.dtype))


def setup_inputs(seed: int = 0) -> dict:
    key = jax.random.key(seed)
    ks = jax.random.split(key, 32)
    f32 = jnp.float32

    def nrm(k, shape, scale=1.0):
        return jax.random.normal(k, shape, f32) * scale

    dt0 = jnp.exp(jax.random.uniform(ks[13], (N_A, M_HEADS), f32, math.log(1e-3), math.log(1e-1)))
    return {
        'x_prompt': nrm(ks[0], (BATCH, SEQ, D_MODEL)),
        'x_sample': nrm(ks[1], (DEC_BATCH, DEC_SEQ, D_MODEL)),
        'state_ssm': nrm(ks[2], (N_A, DEC_BATCH, M_HEADS, M_HEAD_DIM, D_STATE), 0.1),
        'state_mamba_conv': nrm(ks[3], (N_A, DEC_BATCH, M_CONV_W - 1, CONV_DIM)),
        'state_ffn_conv': nrm(ks[4], (DEPTH, DEC_BATCH, F_CONV_W - 1, 2 * D_FF)),
        'cache_k': nrm(ks[5], (DEC_BATCH, PAST_LEN, N_HEADS, HEAD_DIM)),
        'cache_v': nrm(ks[6], (DEC_BATCH, PAST_LEN, N_HEADS, HEAD_DIM)),
        'cache_logf': jax.nn.log_sigmoid(FORGET_BIAS_INIT + nrm(ks[7], (DEC_BATCH, PAST_LEN, N_HEADS))),
        'norm_mix_w': 1.0 + nrm(ks[8], (DEPTH, D_MODEL), 0.02),
        'norm_ffn_w': 1.0 + nrm(ks[9], (DEPTH, D_MODEL), 0.02),
        'mamba_w_in': nrm(ks[10], (N_A, D_MODEL, IN_PROJ_DIM), D_MODEL ** -0.5),
        'mamba_conv_w': nrm(ks[11], (N_A, M_CONV_W, CONV_DIM), M_CONV_W ** -0.5),
        'mamba_conv_b': nrm(ks[12], (N_A, CONV_DIM), 0.02),
        'mamba_dt_bias': dt0 + jnp.log(-jnp.expm1(-dt0)),
        'mamba_A_log': jnp.log(jax.random.uniform(ks[14], (N_A, M_HEADS), f32, 1.0, 16.0)),
        'mamba_D': 1.0 + nrm(ks[15], (N_A, M_HEADS), 0.02),
        'mamba_norm_w': 1.0 + nrm(ks[16], (N_A, D_INNER), 0.02),
        'mamba_w_out': nrm(ks[17], (N_A, D_INNER, D_MODEL), D_INNER ** -0.5),
        'kv_norm_w': 1.0 + nrm(ks[18], (D_MODEL,), 0.02),
        'w_k': nrm(ks[19], (D_MODEL, N_HEADS * HEAD_DIM), D_MODEL ** -0.5),
        'w_v': nrm(ks[20], (D_MODEL, N_HEADS * HEAD_DIM), D_MODEL ** -0.5),
        'w_f': nrm(ks[21], (D_MODEL, N_HEADS), D_MODEL ** -0.5),
        'b_f': FORGET_BIAS_INIT + nrm(ks[22], (N_HEADS,), 0.1),
        'attn_w_q': nrm(ks[23], (N_B, D_MODEL, N_HEADS * HEAD_DIM), D_MODEL ** -0.5),
        'attn_w_o': nrm(ks[24], (N_B, N_HEADS * HEAD_DIM, D_MODEL), (N_HEADS * HEAD_DIM) ** -0.5),
        'ffn_w_up': nrm(ks[25], (DEPTH, D_MODEL, 2 * D_FF), D_MODEL ** -0.5),
        'ffn_conv_w': nrm(ks[26], (DEPTH, F_CONV_W, 2 * D_FF), F_CONV_W ** -0.5),
        'ffn_conv_b': nrm(ks[27], (DEPTH, 2 * D_FF), 0.02),
        'ffn_w_down': nrm(ks[28], (DEPTH, D_FF, D_MODEL), D_FF ** -0.5),
        'final_norm_w': 1.0 + nrm(ks[29], (D_MODEL,), 0.02),
    }


def reference(x_prompt, x_sample, state_ssm, state_mamba_conv, state_ffn_conv, cache_k, cache_v, cache_logf,
              norm_mix_w, norm_ffn_w, mamba_w_in, mamba_conv_w, mamba_conv_b, mamba_dt_bias, mamba_A_log,
              mamba_D, mamba_norm_w, mamba_w_out, kv_norm_w, w_k, w_v, w_f, b_f, attn_w_q, attn_w_o,
              ffn_w_up, ffn_conv_w, ffn_conv_b, ffn_w_down, final_norm_w):
    bp = x_prompt.shape[0]
    z_ssm = jnp.zeros((N_A, bp) + state_ssm.shape[2:], state_ssm.dtype)
    z_mconv = jnp.zeros((N_A, bp) + state_mamba_conv.shape[2:], state_mamba_conv.dtype)
    z_fconv = jnp.zeros((DEPTH, bp) + state_ffn_conv.shape[2:], state_ffn_conv.dtype)
    e_k = jnp.zeros((bp, 0, N_HEADS, HEAD_DIM), cache_k.dtype)
    e_v = jnp.zeros((bp, 0, N_HEADS, HEAD_DIM), cache_v.dtype)
    e_logf = jnp.zeros((bp, 0, N_HEADS), cache_logf.dtype)
    (y_prompt, p_ssm, p_mconv, p_fconv, p_k, p_v, p_logf) = trunk(
        x_prompt, z_ssm, z_mconv, z_fconv, e_k, e_v, e_logf,
        norm_mix_w, norm_ffn_w, mamba_w_in, mamba_conv_w, mamba_conv_b, mamba_dt_bias, mamba_A_log,
        mamba_D, mamba_norm_w, mamba_w_out, kv_norm_w, w_k, w_v, w_f, b_f, attn_w_q, attn_w_o,
        ffn_w_up, ffn_conv_w, ffn_conv_b, ffn_w_down, final_norm_w)
    (y_sample, s_ssm, s_mconv, s_fconv, s_k, s_v, s_logf) = trunk(
        x_sample, state_ssm, state_mamba_conv, state_ffn_conv, cache_k, cache_v, cache_logf,
        norm_mix_w, norm_ffn_w, mamba_w_in, mamba_conv_w, mamba_conv_b, mamba_dt_bias, mamba_A_log,
        mamba_D, mamba_norm_w, mamba_w_out, kv_norm_w, w_k, w_v, w_f, b_f, attn_w_q, attn_w_o,
        ffn_w_up, ffn_conv_w, ffn_conv_b, ffn_w_down, final_norm_w)
    return (y_prompt, y_sample, p_ssm, p_mconv, p_fconv, p_k, p_v, p_logf,
            s_ssm, s_mconv, s_fconv, s_k, s_v, s_logf)
```

```cpp
#include <hip/hip_runtime.h>
#include <hip/hip_cooperative_groups.h>
#include <cstdio>
#include <cstdint>
namespace cg = cooperative_groups;
namespace pg8 {
#define PG8_LAS __attribute__((address_space(3)))
typedef unsigned short bf16_t;
typedef short bf16x8 __attribute__((ext_vector_type(8)));
typedef float f32x4 __attribute__((ext_vector_type(4)));
typedef unsigned u32x4 __attribute__((ext_vector_type(4)));
constexpr int BM = 256, BK = 64, HALF = 128, HTB = HALF * BK * 2  , STAGE_BYTES = 8 * HTB, NXCD = 8, WGM = 8;

__host__ __device__ __forceinline__ int lds_byte(int r, int c) { const int st = (r >> 4) * 2 + (c >> 5), rr = r & 15, cc = c & 31, ob = rr * 64 + cc * 2; return st * 1024 + (ob ^ (((ob >> 9) & 1) << 5)); }
__host__ __device__ __forceinline__ void stage_rc(int b, int& R, int& C) { const int st = b / 1024, sb = b % 1024, swz = sb ^ (((sb >> 9) & 1) << 5); R = (st >> 1) * 16 + swz / 64; C = (st & 1) * 32 + (swz % 64) / 2; }
__host__ __device__ __forceinline__ int perm32(int rho) { const int n = rho >> 4, i = rho & 15; return 8 * (i >> 2) + 4 * n + (i & 3); }

struct Unit { int pm, pn; };
struct Gemm { const bf16_t* A; const bf16_t* Bt; int M, N, K; };

struct StaticOrder {
    int nM, nN, nwg, G, c;
    __host__ __device__ void init(int M, int N, int G_, int c_) { nM = M / BM; nN = N / BM; nwg = nM * nN; G = G_; c = c_; }
    __host__ __device__ bool next(int i, Unit& u) const {
        const long L = (long)i * G + c; if (L >= nwg) return false;
        int wgid = (int)L; { const int q = nwg / NXCD, r = nwg % NXCD, xcd = wgid % NXCD, off = wgid / NXCD; wgid = (xcd < r ? xcd * (q + 1) : r * (q + 1) + (xcd - r) * q) + off; }
        const int nig = WGM * nN, gid = wgid / nig, fm = gid * WGM, gsz = (nM - fm) < WGM ? (nM - fm) : WGM;
        u.pm = fm + ((wgid % nig) % gsz); u.pn = (wgid % nig) / gsz; return true;
    }
    __device__ __forceinline__ void a_ready(const Unit&) const {}
    __device__ __forceinline__ void done(const Unit&) const {}
};

__device__ __forceinline__ unsigned cvt_pk_bf16(float lo, float hi) { unsigned r; asm volatile("v_cvt_pk_bf16_f32 %0, %1, %2" : "=v"(r) : "v"(lo), "v"(hi)); return r; }
typedef float f32x2 __attribute__((ext_vector_type(2)));
__device__ __forceinline__ f32x2 gelu_pk(f32x2 v) {
    const f32x2 av = __builtin_elementwise_abs(v), d = av * 0.2316418882f + 1.0f;
    f32x2 t; t.x = __builtin_amdgcn_rcpf(d.x); t.y = __builtin_amdgcn_rcpf(d.y);
    f32x2 q = t * 0.5307027145f + (-0.7265760135f); q = q * t + 0.7107068705f; q = q * t + (-0.142248368f); q = q * t + 0.127414796f; q = q * t;
    const f32x2 s = (v * v) * (-0.72134752044f);
    f32x2 e; e.x = __builtin_amdgcn_exp2f(s.x); e.y = __builtin_amdgcn_exp2f(s.y);
    const f32x2 m = v * (q * e), r = v - m;
    f32x2 o; o.x = v.x < 0.f ? m.x : r.x; o.y = v.y < 0.f ? m.y : r.y; return o;
}

template <int ACT  > struct EpiBf16 {
    static constexpr bool PERM = true, AFTER_DRAIN = false; static_assert(ACT == 0 || ACT == 1, "EpiBf16: ACT is 0 (none) or 1 (gelu_pk)");
    bf16_t* O; int ldc; const float* bias; int split_cols; size_t split_stride; float scale0;
    __device__ __forceinline__ void operator()(const f32x4 (&acc)[2][2][4][2], const Unit& u, int wr, int wc, int fr, int fq) const {
        const int row0 = u.pm * BM + wr * 64 + fr; int colt = u.pn * BM; bf16_t* base = O;
        float sc = 1.f; if (split_cols) { const int t = colt / split_cols; base += (size_t)t * split_stride; colt -= t * split_cols; if (t == 0) sc = scale0; }
        const int col0 = colt + wc * 32 + 8 * fq, bcol0 = u.pn * BM + wc * 32 + 8 * fq;
        f32x4 bv[2][2];
#pragma unroll
        for (int bj = 0; bj < 2; ++bj)
#pragma unroll
            for (int n = 0; n < 2; ++n) bv[bj][n] = bias ? *(const f32x4*)(bias + bcol0 + bj * HALF + 4 * n) : (f32x4){0.f, 0.f, 0.f, 0.f};
#pragma unroll
        for (int ai = 0; ai < 2; ++ai)
#pragma unroll
            for (int m = 0; m < 4; ++m) { bf16_t* rowp = base + (size_t)(row0 + ai * HALF + m * 16) * ldc + col0;
#pragma unroll
                for (int bj = 0; bj < 2; ++bj) { f32x4 v0 = acc[ai][bj][m][0] + bv[bj][0], v1 = acc[ai][bj][m][1] + bv[bj][1];
                    if (ACT == 1) { f32x2 a = gelu_pk((f32x2){v0[0], v0[1]}), b = gelu_pk((f32x2){v0[2], v0[3]}), c = gelu_pk((f32x2){v1[0], v1[1]}), d = gelu_pk((f32x2){v1[2], v1[3]});
                        v0 = (f32x4){a.x, a.y, b.x, b.y}; v1 = (f32x4){c.x, c.y, d.x, d.y}; }
                    v0 = v0 * sc; v1 = v1 * sc; u32x4 w; w.x = cvt_pk_bf16(v0[0], v0[1]); w.y = cvt_pk_bf16(v0[2], v0[3]); w.z = cvt_pk_bf16(v1[0], v1[1]); w.w = cvt_pk_bf16(v1[2], v1[3]);
                    *(u32x4*)(rowp + bj * HALF) = w; } }
    }
};

struct PanelStats {
    unsigned* xbuf;
    unsigned* cnt;
    unsigned* tmo;
    int ntn; float eps;
    unsigned code;
    __device__ __forceinline__ bool run(const f32x4 (&v)[2][2][4][2], const Unit& u, int wr, int wc, int fr, int fq, PG8_LAS unsigned char* lds, int wid, int lane) const {
        typedef float f32x2v __attribute__((ext_vector_type(2)));
        PG8_LAS f32x2v* P = (PG8_LAS f32x2v*)lds;
        PG8_LAS f32x2v* S = (PG8_LAS f32x2v*)(lds + 8192);
        PG8_LAS unsigned* flag = (PG8_LAS unsigned*)(lds + 8192 + 2048);
#pragma unroll
        for (int ai = 0; ai < 2; ++ai)
#pragma unroll
            for (int m = 0; m < 4; ++m) {
                float s = 0.f;
#pragma unroll
                for (int bj = 0; bj < 2; ++bj)
#pragma unroll
                    for (int n = 0; n < 2; ++n) { const f32x4 x = v[ai][bj][m][n]; s += (x[0] + x[1]) + (x[2] + x[3]); }
                s += __shfl_xor(s, 16); s += __shfl_xor(s, 32);
                const float mw = s * (1.0f / 64.0f); float q = 0.f;
#pragma unroll
                for (int bj = 0; bj < 2; ++bj)
#pragma unroll
                    for (int n = 0; n < 2; ++n) { const f32x4 d = v[ai][bj][m][n] - mw; q += (d[0] * d[0] + d[1] * d[1]) + (d[2] * d[2] + d[3] * d[3]); }
                q += __shfl_xor(q, 16); q += __shfl_xor(q, 32);
                if (fq == 0) P[(ai * HALF + wr * 64 + m * 16 + fr) * 4 + wc] = (f32x2v){mw, q};
            }
        asm volatile("s_waitcnt lgkmcnt(0)" ::: "memory"); __builtin_amdgcn_s_barrier(); asm volatile("" ::: "memory");
#if defined(BROKEN_EXCHANGE_NO_WAIT)
#warning BROKEN CONTROL BUILD: the row-statistics exchange does not wait; results are wrong by design
        if (blockIdx.x >= 64) { const long long t0_ = clock64(); while (clock64() - t0_ < 60000) __builtin_amdgcn_s_sleep(8); }
#endif
        const int row = wid * 32 + (lane & 31);
        if (lane < 32) {
            const f32x2v a = P[row * 4 + 0], b = P[row * 4 + 1], c = P[row * 4 + 2], d = P[row * 4 + 3];
            const float mt = (a.x + b.x + c.x + d.x) * 0.25f;
            const float da = a.x - mt, db = b.x - mt, dc = c.x - mt, dd = d.x - mt;
            const float m2 = (a.y + b.y) + (c.y + d.y) + 64.0f * ((da * da + db * db) + (dc * dc + dd * dd));
            unsigned long long* slot = (unsigned long long*)xbuf + ((size_t)(u.pm * BM + row) * 4 + u.pn);
            __hip_atomic_store(slot, ((unsigned long long)__float_as_uint(m2) << 32) | __float_as_uint(mt), __ATOMIC_RELAXED, __HIP_MEMORY_SCOPE_AGENT);
        }
        asm volatile("s_waitcnt vmcnt(0)" ::: "memory");
        if (lane == 0) __hip_atomic_fetch_add(cnt + 64 * u.pm, 1u, __ATOMIC_RELAXED, __HIP_MEMORY_SCOPE_AGENT);
        if (wid == 0) {
            bool dead = false; const unsigned long long t0 = __builtin_amdgcn_s_memrealtime(); const unsigned want = 8u * (unsigned)ntn;
            for (;;) {
#if defined(BROKEN_EXCHANGE_NO_WAIT)
                break;
#endif
                if ((unsigned)__builtin_amdgcn_readfirstlane(__hip_atomic_load(cnt + 64 * u.pm, __ATOMIC_RELAXED, __HIP_MEMORY_SCOPE_AGENT)) >= want) break;
                if (__builtin_amdgcn_s_memrealtime() - t0 > 2000000ull) {
                    if (lane == 0) { unsigned expect = 0u; __hip_atomic_compare_exchange_strong(tmo + 1, &expect, code | (unsigned)(u.pm & 0xff), __ATOMIC_RELAXED, __ATOMIC_RELAXED, __HIP_MEMORY_SCOPE_AGENT);
                                     __hip_atomic_store(tmo, 1u, __ATOMIC_RELAXED, __HIP_MEMORY_SCOPE_AGENT); }
                    dead = true; break; }
                __builtin_amdgcn_s_sleep(2);
            }
            __builtin_amdgcn_fence(__ATOMIC_ACQUIRE, "agent");
            if (lane == 0) flag[0] = dead ? 1u : 0u;
        }
        asm volatile("s_waitcnt vmcnt(0) lgkmcnt(0)" ::: "memory"); __builtin_amdgcn_s_barrier(); asm volatile("" ::: "memory");
        const bool bad = flag[0] != 0u;
        if (lane < 32) {
            const unsigned long long* slot = (const unsigned long long*)xbuf + (size_t)(u.pm * BM + row) * 4; float mt[4], m2[4]; float ms = 0.f;
#pragma unroll
            for (int t = 0; t < 4; ++t) { if (t < ntn) { const unsigned long long w = __hip_atomic_load(slot + t, __ATOMIC_RELAXED, __HIP_MEMORY_SCOPE_AGENT); mt[t] = __uint_as_float((unsigned)w); m2[t] = __uint_as_float((unsigned)(w >> 32)); } else { mt[t] = 0.f; m2[t] = 0.f; } ms += mt[t]; }
            const float mean = ms / (float)ntn; float q = 0.f;
#pragma unroll
            for (int t = 0; t < 4; ++t) if (t < ntn) { const float dm = mt[t] - mean; q += m2[t] + 256.0f * dm * dm; }
            S[row] = (f32x2v){mean, 1.0f / sqrtf(q / (256.0f * (float)ntn) + eps)};
        }
        asm volatile("s_waitcnt lgkmcnt(0)" ::: "memory"); __builtin_amdgcn_s_barrier(); asm volatile("" ::: "memory");
        return bad;
    }
};
struct EpiLnRes {
    static constexpr bool PERM = false, AFTER_DRAIN = true;
    const float* base; float* out; int ldc; const float* bias; PanelStats st; unsigned poison;
    __device__ __forceinline__ void fused(f32x4 (&acc)[2][2][4][2], const Unit& u, int wr, int wc, int fr, int fq, PG8_LAS unsigned char* lds, int wid, int lane) const {
        typedef float f32x2v __attribute__((ext_vector_type(2)));
        const PG8_LAS f32x2v* S = (const PG8_LAS f32x2v*)(lds + 8192);
        const int col0 = u.pn * BM + wc * 32 + 4 * fq;
#pragma unroll
        for (int bj = 0; bj < 2; ++bj)
#pragma unroll
            for (int n = 0; n < 2; ++n) { const f32x4 bv = bias ? *(const f32x4*)(bias + col0 + bj * HALF + n * 16) : (f32x4){0.f, 0.f, 0.f, 0.f};
#pragma unroll
                for (int ai = 0; ai < 2; ++ai)
#pragma unroll
                    for (int m = 0; m < 4; ++m) acc[ai][bj][m][n] += bv; }
        f32x4 pre[4][2][2];
#pragma unroll
        for (int m = 0; m < 4; ++m) { const size_t off = (size_t)(u.pm * BM + wr * 64 + m * 16 + fr) * ldc + col0;
#pragma unroll
            for (int bj = 0; bj < 2; ++bj)
#pragma unroll
                for (int n = 0; n < 2; ++n) pre[m][bj][n] = *(const f32x4*)(base + off + bj * HALF + n * 16); }
        const bool bad = st.run(acc, u, wr, wc, fr, fq, lds, wid, lane) || poison != 0u;
        const float qnan = __builtin_nanf("");
#pragma unroll
        for (int ai = 0; ai < 2; ++ai)
#pragma unroll
            for (int m = 0; m < 4; ++m) { const int r = ai * HALF + wr * 64 + m * 16 + fr; const f32x2v sr = S[r]; const size_t off = (size_t)(u.pm * BM + r) * ldc + col0;
#pragma unroll
                for (int bj = 0; bj < 2; ++bj)
#pragma unroll
                    for (int n = 0; n < 2; ++n) { const f32x4 bs = ai == 0 ? pre[m][bj][n] : *(const f32x4*)(base + off + bj * HALF + n * 16); f32x4 o = bs + (acc[ai][bj][m][n] - sr.x) * sr.y;
                        if (bad) o = (f32x4){qnan, qnan, qnan, qnan}; *(f32x4*)(out + off + bj * HALF + n * 16) = o; }
                if (m & 1) asm volatile("" ::: "memory"); }
    }
};
struct EpiLnResLn {
    static constexpr bool PERM = false, AFTER_DRAIN = true;
    const float* base; float* out; bf16_t* xn; int ldc; const float* bias; PanelStats st1, st2; unsigned poison;
    __device__ __forceinline__ void fused(f32x4 (&acc)[2][2][4][2], const Unit& u, int wr, int wc, int fr, int fq, PG8_LAS unsigned char* lds, int wid, int lane) const {
        typedef float f32x2v __attribute__((ext_vector_type(2))); typedef unsigned u32x2v __attribute__((ext_vector_type(2)));
        const PG8_LAS f32x2v* S = (const PG8_LAS f32x2v*)(lds + 8192);
        const int col0 = u.pn * BM + wc * 32 + 4 * fq;
#pragma unroll
        for (int bj = 0; bj < 2; ++bj)
#pragma unroll
            for (int n = 0; n < 2; ++n) { const f32x4 bv = bias ? *(const f32x4*)(bias + col0 + bj * HALF + n * 16) : (f32x4){0.f, 0.f, 0.f, 0.f};
#pragma unroll
                for (int ai = 0; ai < 2; ++ai)
#pragma unroll
                    for (int m = 0; m < 4; ++m) acc[ai][bj][m][n] += bv; }
        bool bad = st1.run(acc, u, wr, wc, fr, fq, lds, wid, lane) || poison != 0u;
        const float qnan = __builtin_nanf("");
#pragma unroll
        for (int ai = 0; ai < 2; ++ai)
#pragma unroll
            for (int m = 0; m < 4; ++m) { const int r = ai * HALF + wr * 64 + m * 16 + fr; const f32x2v sr = S[r]; const size_t off = (size_t)(u.pm * BM + r) * ldc + col0;
#pragma unroll
                for (int bj = 0; bj < 2; ++bj)
#pragma unroll
                    for (int n = 0; n < 2; ++n) { const f32x4 bs = *(const f32x4*)(base + off + bj * HALF + n * 16); acc[ai][bj][m][n] = bs + (acc[ai][bj][m][n] - sr.x) * sr.y; }
                asm volatile("" : "+v"(acc[ai][0][m][0]), "+v"(acc[ai][0][m][1]), "+v"(acc[ai][1][m][0]), "+v"(acc[ai][1][m][1]));
                if (m & 1) asm volatile("" ::: "memory"); }
        const bool bad1 = bad;
        bad = st2.run(acc, u, wr, wc, fr, fq, lds, wid, lane) || bad;
#pragma unroll
        for (int ai = 0; ai < 2; ++ai)
#pragma unroll
            for (int m = 0; m < 4; ++m) { const int r = ai * HALF + wr * 64 + m * 16 + fr; const f32x2v sr = S[r]; const size_t off = (size_t)(u.pm * BM + r) * ldc + col0;
#pragma unroll
                for (int bj = 0; bj < 2; ++bj)
#pragma unroll
                    for (int n = 0; n < 2; ++n) { const f32x4 x1 = acc[ai][bj][m][n]; *(f32x4*)(out + off + bj * HALF + n * 16) = bad1 ? (f32x4){qnan, qnan, qnan, qnan} : x1;
                        const f32x4 o = (x1 - sr.x) * sr.y; u32x2v w; w.x = cvt_pk_bf16(o[0], o[1]); w.y = cvt_pk_bf16(o[2], o[3]);
                        if (bad) { w.x = 0x7fc07fc0u; w.y = 0x7fc07fc0u; } *(u32x2v*)(xn + off + bj * HALF + n * 16) = w; }
                asm volatile("" ::: "memory"); }
    }
};

template <class Epi, class Sched, bool ALIGN_EPI = false, bool SP2 = false>
__device__ __forceinline__ void gemm_phase(PG8_LAS unsigned char* lds, const Gemm g, const Sched& S, const Epi& E) {
    const int tid = threadIdx.x, wid = __builtin_amdgcn_readfirstlane(tid >> 6), lane = tid & 63, wr = wid >> 2, wc = wid & 3, fr = lane & 15, fq = lane >> 4;
    const int K = g.K, nt = K / BK;
    unsigned voffA[2], voffB[2];
#pragma unroll
    for (int i = 0; i < 2; ++i) { int R, C; stage_rc(tid * 16 + i * 8192, R, C); const int Rb = Epi::PERM ? ((R & ~31) + perm32(R & 31)) : R;
        voffA[i] = (unsigned)(R * K + C) * 2u; voffB[i] = (unsigned)(Rb * K + C) * 2u; }
    const size_t kstep = (size_t)(BK * 2);
    const size_t hstep = (size_t)HALF * K * 2;
    const size_t tstep = 2 * hstep;
    const unsigned ldsw = (unsigned)wid * 1024u;
    const int aoff = lds_byte(wr * 64 + fr, fq * 8), boff = lds_byte(wc * 32 + fr, fq * 8);
#define PG8_SA(b, h) (((b) * 2 + (h)) * HTB)
#define PG8_SB(b, h) ((4 + (b) * 2 + (h)) * HTB)
#define PG8_STAGE(bufoff, gbase, voff) do { _Pragma("unroll") for (int _i = 0; _i < 2; ++_i) \
        __builtin_amdgcn_global_load_lds((const unsigned*)((const char*)(gbase) + (voff)[_i]), (PG8_LAS unsigned*)(lds + (bufoff) + ldsw + _i * 8192), 16, 0, 0); } while (0)
#define PG8_LDA(dst, b, h) do { _Pragma("unroll") for (int m = 0; m < 4; ++m) _Pragma("unroll") for (int k = 0; k < 2; ++k) dst[m][k] = *(const PG8_LAS bf16x8*)(lds + PG8_SA(b, h) + aoff + m * 2048 + k * 1024); } while (0)
#define PG8_LDB(dst, b, h) do { _Pragma("unroll") for (int n = 0; n < 2; ++n) _Pragma("unroll") for (int k = 0; k < 2; ++k) dst[n][k] = *(const PG8_LAS bf16x8*)(lds + PG8_SB(b, h) + boff + n * 2048 + k * 1024); } while (0)
#define PG8_MMA(ai, bj, At, Bt) do { __builtin_amdgcn_s_setprio(1); _Pragma("unroll") for (int m = 0; m < 4; ++m) _Pragma("unroll") for (int n = 0; n < 2; ++n) _Pragma("unroll") for (int k = 0; k < 2; ++k) \
        acc[ai][bj][m][n] = __builtin_amdgcn_mfma_f32_16x16x32_bf16(Bt[n][k], At[m][k], acc[ai][bj][m][n], 0, 0, 0); __builtin_amdgcn_s_setprio(0); } while (0)
#define PG8_WAIT_V(n) asm volatile("s_waitcnt vmcnt(" #n ")" ::: "memory")
#define PG8_WAIT_L(n) asm volatile("s_waitcnt lgkmcnt(" #n ")" ::: "memory")
#define PG8_BAR __builtin_amdgcn_s_barrier()
#define PG8_SCHED __builtin_amdgcn_sched_barrier(0)
    Unit cur, nxt; int ui = 0;
    if (!S.next(0, cur)) return;
    f32x4 acc[2][2][4][2];
#pragma unroll
    for (int a = 0; a < 2; ++a)
#pragma unroll
        for (int b = 0; b < 2; ++b)
#pragma unroll
            for (int m = 0; m < 4; ++m)
#pragma unroll
                for (int n = 0; n < 2; ++n) acc[a][b][m][n] = (f32x4){0.f, 0.f, 0.f, 0.f};
    bf16x8 At[4][2], B0[2][2], B1[2][2];
    const char* cA = (const char*)g.A + (size_t)cur.pm * tstep; const char* cB = (const char*)g.Bt + (size_t)cur.pn * tstep;
    S.a_ready(cur);
    if constexpr (SP2) {
        PG8_STAGE(PG8_SB(0, 0), cB, voffB); PG8_STAGE(PG8_SB(0, 1), cB + hstep, voffB); PG8_STAGE(PG8_SA(0, 0), cA, voffA); PG8_STAGE(PG8_SA(0, 1), cA + hstep, voffA);
        if (wr == 1) PG8_BAR;
        PG8_WAIT_V(2); PG8_BAR;
        PG8_STAGE(PG8_SB(1, 0), cB + kstep, voffB); PG8_STAGE(PG8_SA(1, 0), cA + kstep, voffA); PG8_STAGE(PG8_SB(1, 1), cB + hstep + kstep, voffB);
        PG8_WAIT_V(6); PG8_BAR;
    } else {
        PG8_STAGE(PG8_SB(0, 0), cB, voffB); PG8_STAGE(PG8_SA(0, 0), cA, voffA); PG8_STAGE(PG8_SB(0, 1), cB + hstep, voffB); PG8_STAGE(PG8_SA(0, 1), cA + hstep, voffA);
        if (wr == 1) PG8_BAR;
        PG8_WAIT_V(4); PG8_BAR;
        PG8_STAGE(PG8_SB(1, 0), cB + kstep, voffB); PG8_STAGE(PG8_SA(1, 0), cA + kstep, voffA); PG8_STAGE(PG8_SB(1, 1), cB + hstep + kstep, voffB);
        PG8_WAIT_V(6); PG8_BAR;
    }
    for (;;) {
        const bool has_next = S.next(ui + 1, nxt);
        const char* nA = has_next ? (const char*)g.A + (size_t)nxt.pm * tstep : cA; const char* nB = has_next ? (const char*)g.Bt + (size_t)nxt.pn * tstep : cB;
        for (int t = 0; t < nt; t += 2) {
            const bool last = (t == nt - 2);
            const char* a1 = cA + (size_t)(t + 1) * kstep;
            const char* a2 = last ? nA : cA + (size_t)(t + 2) * kstep; const char* b2 = last ? nB : cB + (size_t)(t + 2) * kstep;
            const char* a3 = a2 + kstep; const char* b3 = b2 + kstep;
            if (last && has_next) S.a_ready(nxt);
            if constexpr (SP2) {
            PG8_LDB(B0, 0, 0); PG8_LDB(B1, 0, 1); PG8_SCHED; PG8_LDA(At, 0, 0); PG8_STAGE(PG8_SA(1, 1), a1 + hstep, voffA);
            PG8_WAIT_V(8); PG8_WAIT_L(0); PG8_BAR; PG8_MMA(0, 0, At, B0); PG8_MMA(0, 1, At, B1); PG8_BAR; PG8_SCHED;
            PG8_LDA(At, 0, 1); PG8_STAGE(PG8_SB(0, 0), b2, voffB); PG8_STAGE(PG8_SB(0, 1), b2 + hstep, voffB); PG8_STAGE(PG8_SA(0, 0), a2, voffA);
            PG8_WAIT_V(8); PG8_WAIT_L(0); PG8_BAR; PG8_MMA(1, 0, At, B0); PG8_MMA(1, 1, At, B1); PG8_BAR; PG8_SCHED;
            PG8_LDB(B0, 1, 0); PG8_LDB(B1, 1, 1); PG8_SCHED; PG8_LDA(At, 1, 0); PG8_STAGE(PG8_SA(0, 1), a2 + hstep, voffA);
            PG8_WAIT_V(8); PG8_WAIT_L(0); PG8_BAR; PG8_MMA(0, 0, At, B0); PG8_MMA(0, 1, At, B1); PG8_BAR; PG8_SCHED;
            PG8_LDA(At, 1, 1); PG8_STAGE(PG8_SB(1, 0), b3, voffB); PG8_STAGE(PG8_SB(1, 1), b3 + hstep, voffB); PG8_STAGE(PG8_SA(1, 0), a3, voffA);
            PG8_WAIT_V(8); PG8_WAIT_L(0); PG8_BAR; PG8_MMA(1, 0, At, B0); PG8_MMA(1, 1, At, B1); PG8_BAR; PG8_SCHED;
            } else {
            PG8_LDB(B0, 0, 0); PG8_SCHED; PG8_LDA(At, 0, 0); PG8_STAGE(PG8_SA(1, 1), a1 + hstep, voffA);
            PG8_WAIT_L(8); PG8_BAR; PG8_WAIT_L(0); PG8_MMA(0, 0, At, B0); PG8_BAR; PG8_SCHED;
            PG8_LDB(B1, 0, 1); PG8_STAGE(PG8_SB(0, 0), b2, voffB);
            PG8_BAR; PG8_WAIT_L(0); PG8_MMA(0, 1, At, B1); PG8_BAR;
            PG8_LDA(At, 0, 1); PG8_STAGE(PG8_SA(0, 0), a2, voffA);
            PG8_BAR; PG8_WAIT_L(0); PG8_MMA(1, 0, At, B0); PG8_BAR; PG8_SCHED;
            PG8_STAGE(PG8_SB(0, 1), b2 + hstep, voffB);
            PG8_WAIT_V(6); PG8_BAR; PG8_MMA(1, 1, At, B1); PG8_BAR;
            PG8_LDB(B0, 1, 0); PG8_SCHED; PG8_LDA(At, 1, 0); PG8_STAGE(PG8_SA(0, 1), a2 + hstep, voffA);
            PG8_WAIT_L(8); PG8_BAR; PG8_WAIT_L(0); PG8_MMA(0, 0, At, B0); PG8_BAR; PG8_SCHED;
            PG8_LDB(B1, 1, 1); PG8_STAGE(PG8_SB(1, 0), b3, voffB);
            PG8_BAR; PG8_WAIT_L(0); PG8_MMA(0, 1, At, B1); PG8_BAR;
            PG8_LDA(At, 1, 1); PG8_STAGE(PG8_SA(1, 0), a3, voffA);
            PG8_BAR; PG8_WAIT_L(0); PG8_MMA(1, 0, At, B0); PG8_BAR; PG8_SCHED;
            PG8_STAGE(PG8_SB(1, 1), b3 + hstep, voffB);
            PG8_WAIT_V(6); PG8_BAR; PG8_MMA(1, 1, At, B1); PG8_BAR;
            }
        }
        if constexpr (ALIGN_EPI) { if (wr == 0) PG8_BAR; }
        if constexpr (!Epi::AFTER_DRAIN) { E(acc, cur, wr, wc, fr, fq); S.done(cur); }
        if (!has_next) break;
#pragma unroll
        for (int a = 0; a < 2; ++a)
#pragma unroll
            for (int b = 0; b < 2; ++b)
#pragma unroll
                for (int m = 0; m < 4; ++m)
#pragma unroll
                    for (int n = 0; n < 2; ++n) acc[a][b][m][n] = (f32x4){0.f, 0.f, 0.f, 0.f};
        cur = nxt; cA = nA; cB = nB; ++ui;
        if constexpr (ALIGN_EPI) { if (wr == 1) PG8_BAR; }
    }
    PG8_WAIT_V(0);
    if constexpr (!ALIGN_EPI) { if (wr == 0) PG8_BAR; }
    PG8_BAR;
    if constexpr (Epi::AFTER_DRAIN) { E.fused(acc, cur, wr, wc, fr, fq, lds, wid, lane); S.done(cur); }
#undef PG8_SA
#undef PG8_SB
#undef PG8_STAGE
#undef PG8_LDA
#undef PG8_LDB
#undef PG8_MMA
#undef PG8_WAIT_V
#undef PG8_WAIT_L
#undef PG8_BAR
#undef PG8_SCHED
}
}
#include <hip/hip_bf16.h>
#include <cmath>
namespace attn_body {
using bf16=__hip_bfloat16;
using bf16x8=__attribute__((ext_vector_type(8)))short;
using s16x4=__attribute__((ext_vector_type(4)))short;
using f32x16=__attribute__((ext_vector_type(16)))float;
using u32x4=__attribute__((ext_vector_type(4)))unsigned;
using f32x4_t=__attribute__((ext_vector_type(4)))float;
__device__ __forceinline__ unsigned f2bf_(float f){unsigned u=__builtin_bit_cast(unsigned,f);return (u+0x7fffu+((u>>16)&1u))>>16;}
constexpr int BATCH=1,NHEAD=16,SEQ=16384,D=64,DM=NHEAD*D;
constexpr int NW=8,QBLK=32,QB=QBLK*NW,KVBLK=64,NQB=SEQ/QB;
constexpr int ATTN_PITCH=DM, ATTN_UNIT_ROWS=QB;
__device__ __forceinline__ int crow(int r,int hi){return (r&3)+8*(r>>2)+4*hi;}
#define SBAR() __builtin_amdgcn_sched_barrier(0)
__device__ __forceinline__ void cmask(f32x16&p0,f32x16&p1,int jb,int qrel,int hi){
  const float NEG=-INFINITY; int kb=64*jb+4*hi;
  #pragma unroll
  for(int r=0;r<16;++r){int kv=kb+(r&3)+8*(r>>2); if(kv>qrel)p0[r]=NEG; if(kv+32>qrel)p1[r]=NEG;}
}

constexpr int NSLOT=3, SLOTB=8192;
constexpr int LDS_K=0, LDS_V=NSLOT*SLOTB, LDS_WS=2*NSLOT*SLOTB, LDS_OST=LDS_WS+NW*64*4, LDS_CT=LDS_OST+NW*4096, LDS_BYTES=LDS_CT+SEQ*4;
constexpr float C2=0.125f*1.4426950408889634f;
__device__ __forceinline__ void glds16(const void*gsrc,unsigned lds_dst){unsigned keep;
  asm volatile("s_mov_b32 %0, m0\n\ts_mov_b32 m0, %2\n\ts_nop 0\n\tglobal_load_lds_dwordx4 %1, off\n\ts_mov_b32 m0, %0":"=&s"(keep):"v"(gsrc),"s"(lds_dst):"memory");}
__device__ __forceinline__ float max3f(float a,float b,float c){float r;asm("v_max3_f32 %0, %1, %2, %3":"=v"(r):"v"(a),"v"(b),"v"(c));return r;}
__device__ __forceinline__ float max2f(float a,float b){float r;asm("v_max_f32_e32 %0, %1, %2":"=v"(r):"v"(a),"v"(b));return r;}
__device__ __forceinline__ float fadd_s(float a,float b){float r;asm("v_add_f32_e32 %0, %1, %2":"=v"(r):"v"(a),"v"(b));return r;}
__device__ __forceinline__ float fsub_s(float a,float b){float r;asm("v_sub_f32_e32 %0, %1, %2":"=v"(r):"v"(a),"v"(b));return r;}
typedef float f32x2_t __attribute__((ext_vector_type(2))); typedef __bf16 bf16x2_t __attribute__((ext_vector_type(2)));
__device__ __forceinline__ unsigned cvtpk_s(float lo,float hi){f32x2_t v={lo,hi};bf16x2_t b=__builtin_convertvector(v,bf16x2_t);return __builtin_bit_cast(unsigned,b);}
#define WAIT_BAR(N) asm volatile("s_waitcnt vmcnt(" #N ") lgkmcnt(0)\n\ts_barrier":::"memory")

__device__ __forceinline__ void qkt(f32x16&p0,f32x16&p1,const char*Kslot,const bf16x8*qr,int r32,int hi,bf16x8 kbA,bf16x8 kbB,bf16x8 qx){
  const f32x16 z16=f32x16{};
  p0=__builtin_amdgcn_mfma_f32_32x32x16_bf16(kbA,qx,z16,0,0,0);p1=__builtin_amdgcn_mfma_f32_32x32x16_bf16(kbB,qx,z16,0,0,0);
  const char*kb=Kslot+hi*1024+r32*16;
  #pragma unroll
  for(int d0=0;d0<4;++d0){
    const bf16x8 b0=*reinterpret_cast<const bf16x8*>(kb+d0*2048);
    const bf16x8 b1=*reinterpret_cast<const bf16x8*>(kb+d0*2048+512);
    p0=__builtin_amdgcn_mfma_f32_32x32x16_bf16(b0,qr[d0],p0,0,0,0);p1=__builtin_amdgcn_mfma_f32_32x32x16_bf16(b1,qr[d0],p1,0,0,0);}
}
typedef __attribute__((address_space(3))) const char* lds_cptr;
typedef short v4i16_t __attribute__((ext_vector_type(4)));
__device__ __forceinline__ void kload8(bf16x8*kf,lds_cptr kp){
  kf[0]=*(const __attribute__((address_space(3))) bf16x8*)(kp);      kf[1]=*(const __attribute__((address_space(3))) bf16x8*)(kp+512);
  kf[2]=*(const __attribute__((address_space(3))) bf16x8*)(kp+2048); kf[3]=*(const __attribute__((address_space(3))) bf16x8*)(kp+2560);
  kf[4]=*(const __attribute__((address_space(3))) bf16x8*)(kp+4096); kf[5]=*(const __attribute__((address_space(3))) bf16x8*)(kp+4608);
  kf[6]=*(const __attribute__((address_space(3))) bf16x8*)(kp+6144); kf[7]=*(const __attribute__((address_space(3))) bf16x8*)(kp+6656);
}
__device__ __forceinline__ void kload2(bf16x8*kf,lds_cptr kp,int j){ kf[2*j]=*(const __attribute__((address_space(3))) bf16x8*)(kp+j*2048); kf[2*j+1]=*(const __attribute__((address_space(3))) bf16x8*)(kp+j*2048+512); }
__device__ __forceinline__ s16x4 vtr(lds_cptr p){ return __builtin_bit_cast(s16x4,__builtin_amdgcn_ds_read_tr16_b64_v4i16((__attribute__((address_space(3))) v4i16_t*)p)); }
__device__ __forceinline__ float rowmax(const f32x16&p0,const f32x16&p1){
  float a=max3f(p0[0],p0[1],p1[0]),b=max3f(p0[2],p0[3],p1[1]);a=max3f(a,p1[2],p1[3]);
  #pragma unroll
  for(int r=4;r<16;r+=4){a=max3f(a,p0[r],p0[r+1]);b=max3f(b,p0[r+2],p0[r+3]);a=max3f(a,p1[r],p1[r+1]);b=max3f(b,p1[r+2],p1[r+3]);}
  const float m=max2f(a,b);
  auto rr=__builtin_amdgcn_permlane32_swap(__float_as_uint(m),__float_as_uint(m),false,false);
  return max2f(__uint_as_float(rr[0]),__uint_as_float(rr[1]));
}
__device__ __forceinline__ void pv(f32x16*o,int vb,bf16x8 pa0,bf16x8 pa1,bf16x8 pa2,bf16x8 pa3){
  #pragma unroll
  for(int d0=0;d0<2;++d0){s16x4 lo[4],hi[4];
    #pragma unroll
    for(int ks=0;ks<4;++ks){
      asm volatile("ds_read_b64_tr_b16 %0,%1 offset:%c2":"=&v"(lo[ks]):"v"(vb),"i"(d0*4096+ks*1024):"memory");
      asm volatile("ds_read_b64_tr_b16 %0,%1 offset:%c2":"=&v"(hi[ks]):"v"(vb),"i"(d0*4096+ks*1024+512):"memory");}
    asm volatile("s_waitcnt lgkmcnt(0)":::"memory");SBAR();
    #define PK(k) (bf16x8){lo[k][0],lo[k][1],lo[k][2],lo[k][3],hi[k][0],hi[k][1],hi[k][2],hi[k][3]}
    o[d0]=__builtin_amdgcn_mfma_f32_32x32x16_bf16(pa0,PK(0),o[d0],0,0,0);
    o[d0]=__builtin_amdgcn_mfma_f32_32x32x16_bf16(pa1,PK(1),o[d0],0,0,0);
    o[d0]=__builtin_amdgcn_mfma_f32_32x32x16_bf16(pa2,PK(2),o[d0],0,0,0);
    o[d0]=__builtin_amdgcn_mfma_f32_32x32x16_bf16(pa3,PK(3),o[d0],0,0,0);
    #undef PK
  }
}

#ifndef ATTN_STORE16
#define ATTN_STORE16(p,v) (*(u32x4*)(p)=(v))
#endif
template<int THRL> __device__ __forceinline__ void attn_unit(int b,int h,int qb,const bf16*Q,const bf16*__restrict__ K,const bf16*__restrict__ V,bf16*O,char*shm,const float*__restrict__ cbh){
  const int tid=threadIdx.x,lane=tid&63,r32=lane&31,hi=lane>>5; const int wid=__builtin_amdgcn_readfirstlane(tid>>6);
  const long rowbase=(long)b*SEQ; const int q0=qb*QB;
  const bf16*Qw=Q+(rowbase+q0+wid*QBLK)*DM+h*D;
  const bf16*Kh=K+rowbase*DM+h*D,*Vh=V+rowbase*DM+h*D;
  const unsigned lds0=(unsigned)(uintptr_t)shm;
  float*wsf=(float*)(shm+LDS_WS)+wid*64;
  const bf16*ksrc=Kh+(long)lane*DM+wid*8;
  const bf16*vsrc=Vh+(long)(16*(wid&3)+(lane>>2))*DM+(wid>>2)*32+(lane&3)*8;
  const unsigned kdst=lds0+LDS_K+wid*1024, vdst=lds0+LDS_V+wid*1024;
  #define DMA_K(t,slot) glds16(ksrc+(long)(t)*KVBLK*DM,(unsigned)__builtin_amdgcn_readfirstlane(kdst+(slot)))
  #define DMA_V(t,slot) glds16(vsrc+(long)(t)*KVBLK*DM,(unsigned)__builtin_amdgcn_readfirstlane(vdst+(slot)))
  const int vb0=(int)(lds0+LDS_V)+((lane>>4)&1)*32+(lane&3)*8+(4*hi+((lane&15)>>2))*64;
  const char*Kbase=shm+LDS_K; bf16x8 kf[8];
  const lds_cptr shm3=(lds_cptr)shm; const lds_cptr kp0=shm3+LDS_K+hi*1024+r32*16; const lds_cptr vp0=shm3+LDS_V+((lane>>4)&1)*32+(lane&3)*8+(4*hi+((lane&15)>>2))*64;
  const int NT=(q0+QB)/KVBLK;
  { typedef __attribute__((address_space(3))) f32x4_t* l4p; const l4p ct4=(l4p)(shm3+LDS_CT); const f32x4_t* g4=(const f32x4_t*)cbh;
    for(int i=tid;i<NT*16;i+=NW*64) ct4[i]=g4[i];
    asm volatile("s_waitcnt vmcnt(0) lgkmcnt(0)\n\ts_barrier":::"memory"); }
  const __attribute__((address_space(3))) float* ctab=(const __attribute__((address_space(3))) float*)(shm3+LDS_CT)+r32;
  #define MKQX(mv) ({ const float c_=(mv); const unsigned u1=f2bf_(c_); const float r1_=c_-__uint_as_float(u1<<16); const unsigned u2=f2bf_(r1_); const float r2_=r1_-__uint_as_float(u2<<16); const unsigned u3=f2bf_(r2_); u32x4 t_={0x3F803F80u,0x00003F80u|(u1<<16),u2|(u3<<16),0u}; if(hi){t_=(u32x4){0u,0u,0u,0u};} __builtin_bit_cast(bf16x8,t_); })
  bf16x8 qx=MKQX(0.f);
  #define KBIAS(cv) ({ const float c_=(cv); const unsigned u1=f2bf_(c_); const float r1_=c_-__uint_as_float(u1<<16); const unsigned u2=f2bf_(r1_); const float r2_=r1_-__uint_as_float(u2<<16); const unsigned u3=f2bf_(r2_); u32x4 t_={u1|(u2<<16),u3|0x3F800000u,0x3F803F80u,0u}; __builtin_bit_cast(bf16x8,t_); })
  DMA_K(0,0);DMA_V(0,0);DMA_K(1,SLOTB);
  bf16x8 qr[4];
  #pragma unroll
  for(int d0=0;d0<4;++d0)qr[d0]=*reinterpret_cast<const bf16x8*>(&Qw[(long)r32*DM+d0*16+hi*8]);
  float mhat=0.f,l_reg=0.f;f32x16 o[2];o[0]=f32x16{};o[1]=f32x16{};
  const int qrel=wid*QBLK+r32;
  #define CMASK(P0,P1,t) do{int jb_=(t)-(NT-4); if(jb_>=0)cmask(P0,P1,jb_,qrel,hi);}while(0)
  bool resc=false;
  #define START(P0,P1) do{ const float rm=rowmax(P0,P1); resc=false; \
    { const float dl=rm; mhat=fadd_s(mhat,dl); \
      _Pragma("unroll") for(int r=0;r<16;++r){P0[r]=fsub_s(P0[r],dl);P1[r]=fsub_s(P1[r],dl);} \
      qx=MKQX(-mhat); } \
    _Pragma("unroll") for(int r=0;r<16;++r)P0[r]=__builtin_amdgcn_exp2f(P0[r]); }while(0)
  #define RESC() do{ if(resc){ asm volatile("s_waitcnt lgkmcnt(0)":::"memory"); \
      _Pragma("unroll") for(int d_=0;d_<2;++d_) _Pragma("unroll") for(int r=0;r<16;++r)o[d_][r]*=wsf[crow(r,hi)]; } }while(0)
  f32x16 pA0,pA1,pB0,pB1;
  int sl_prev=0,sl_cur=0,sl_next=SLOTB;
  #define ROT() do{sl_prev=sl_cur;sl_cur=sl_next;sl_next=(sl_next==(NSLOT-1)*SLOTB)?0:sl_next+SLOTB;}while(0)
  DMA_K(2,2*SLOTB);
  WAIT_BAR(3);
  qkt(pA0,pA1,Kbase,qr,r32,hi,KBIAS(ctab[0]),KBIAS(ctab[32]),qx);asm volatile("s_nop 15\n\ts_nop 7":"+v"(pA0),"+v"(pA1));CMASK(pA0,pA1,0);
  START(pA0,pA1);
  _Pragma("unroll") for(int r=0;r<16;++r)pA1[r]=__builtin_amdgcn_exp2f(pA1[r]);
  WAIT_BAR(0);
  DMA_K(3,0);DMA_V(1,SLOTB);
  ROT();
  kload8(kf,kp0+sl_cur);
  WAIT_BAR(2);
  s16x4 vlo[8],vhi[8]; u32x4 pw0,pw1,pw2,pw3;
  #define PKW(P,B) cvtpk_s(P[B],P[B+1])
  #define PAF(k) __builtin_bit_cast(bf16x8,pw##k)
  #define VFR(i) (bf16x8){vlo[i][0],vlo[i][1],vlo[i][2],vlo[i][3],vhi[i][0],vhi[i][1],vhi[i][2],vhi[i][3]}
  #define PIN(x) asm volatile("":"+v"(x))
  #define MX3(a,b,c) __builtin_fmaxf(__builtin_fmaxf((a),(b)),(c))
  #define GAPA(MF,A0,A1,A2,A3,W0,W1,PW) do{ MF; sacc+=A0; sacc+=A1; sacc+=A2; sacc+=A3; PIN(sacc); W0; W1; PIN(PW); SBAR(); }while(0)
  #define EX(v) __builtin_amdgcn_exp2f(v)
  #define GAPB(MF,X,B) do{ MF; X[B]=EX(X[B]); X[B+1]=EX(X[B+1]); X[B+2]=EX(X[B+2]); X[B+3]=EX(X[B+3]); PIN(X); SBAR(); }while(0)
  #define VRD(i) do{ vlo[i]=vtr(vp_+(((i)>>2)*4096+((i)&3)*1024)); vhi[i]=vtr(vp_+(((i)>>2)*4096+((i)&3)*1024+512)); }while(0)
  #define KRD(G,j) do{ if(G){ kload2(kf,kp0+sl_next,j); SBAR(); } }while(0)
  #define STEP(C0,C1,P0,P1,t,GK,GV,GL) do{ SBAR(); \
    const lds_cptr vp_=vp0+sl_prev; \
    { const bf16x8 kbA_=KBIAS(ctab[(t)*64]), kbB_=KBIAS(ctab[(t)*64+32]); \
      const f32x16 z16_=f32x16{}; C0=__builtin_amdgcn_mfma_f32_32x32x16_bf16(kbA_,qx,z16_,0,0,0); C1=__builtin_amdgcn_mfma_f32_32x32x16_bf16(kbB_,qx,z16_,0,0,0); } SBAR(); \
    VRD(0); SBAR(); float sacc=(P0[0]+P0[1]); \
    GAPA(C0=__builtin_amdgcn_mfma_f32_32x32x16_bf16(kf[0],qr[0],C0,0,0,0), P0[2],P0[3],P0[4],P0[5],     pw0[0]=PKW(P0,0), pw0[1]=PKW(P0,2), pw0); \
    VRD(4); SBAR(); GAPA(C1=__builtin_amdgcn_mfma_f32_32x32x16_bf16(kf[1],qr[0],C1,0,0,0), P0[6],P0[7],P0[8],P0[9],     pw0[2]=PKW(P0,4), pw0[3]=PKW(P0,6), pw0); \
    VRD(1); SBAR(); GAPA(C0=__builtin_amdgcn_mfma_f32_32x32x16_bf16(kf[2],qr[1],C0,0,0,0),   P0[10],P0[11],P0[12],P0[13], pw1[0]=PKW(P0,8), pw1[1]=PKW(P0,10), pw1); \
    VRD(5); SBAR(); GAPA(C1=__builtin_amdgcn_mfma_f32_32x32x16_bf16(kf[3],qr[1],C1,0,0,0),   P0[14],P0[15],P1[0],P1[1],   pw1[2]=PKW(P0,12),pw1[3]=PKW(P0,14), pw1); \
    VRD(2); SBAR(); GAPA(C0=__builtin_amdgcn_mfma_f32_32x32x16_bf16(kf[4],qr[2],C0,0,0,0),   P1[2],P1[3],P1[4],P1[5],     pw2[0]=PKW(P1,0), pw2[1]=PKW(P1,2), pw2); \
    VRD(6); SBAR(); GAPA(C1=__builtin_amdgcn_mfma_f32_32x32x16_bf16(kf[5],qr[2],C1,0,0,0),   P1[6],P1[7],P1[8],P1[9],     pw2[2]=PKW(P1,4), pw2[3]=PKW(P1,6), pw2); \
    VRD(3); SBAR(); GAPA(C0=__builtin_amdgcn_mfma_f32_32x32x16_bf16(kf[6],qr[3],C0,0,0,0),   P1[10],P1[11],P1[12],P1[13], pw3[0]=PKW(P1,8), pw3[1]=PKW(P1,10), pw3); \
    VRD(7); SBAR(); GAPA(C1=__builtin_amdgcn_mfma_f32_32x32x16_bf16(kf[7],qr[3],C1,0,0,0),   P1[14],P1[15],0.f,0.f,       pw3[2]=PKW(P1,12),pw3[3]=PKW(P1,14), pw3); \
    l_reg+=sacc; \
    if(GK){DMA_K((t)+3,sl_cur);} if(GV){DMA_V((t)+1,sl_next);} \
    CMASK(C0,C1,t); \
    { float a=MX3(C0[0],C0[1],C1[0]),b=MX3(C0[2],C0[3],C1[1]); a=MX3(a,C1[2],C1[3]); \
      _Pragma("unroll") for(int r=4;r<16;r+=4){a=MX3(a,C0[r],C0[r+1]);b=MX3(b,C0[r+2],C0[r+3]);a=MX3(a,C1[r],C1[r+1]);b=MX3(b,C1[r+2],C1[r+3]);} \
      float rm=__builtin_fmaxf(a,b); { auto rr=__builtin_amdgcn_permlane32_swap(__float_as_uint(rm),__float_as_uint(rm),false,false); rm=__builtin_fmaxf(__uint_as_float(rr[0]),__uint_as_float(rr[1])); } \
      resc=false; \
      if(__builtin_expect(__any(rm>(float)THRL),0)){ const float dl=__builtin_fmaxf(rm,0.f); mhat+=dl; \
        _Pragma("unroll") for(int r=0;r<16;++r){C0[r]-=dl;C1[r]-=dl;} \
        qx=MKQX(-mhat); \
        const float f=__builtin_amdgcn_exp2f(-dl); l_reg*=f; if(hi==0)wsf[r32]=f; resc=true; } } \
    SBAR(); \
    GAPB(o[0]=__builtin_amdgcn_mfma_f32_32x32x16_bf16(PAF(0),VFR(0),o[0],0,0,0), C0,0); \
    GAPB(o[1]=__builtin_amdgcn_mfma_f32_32x32x16_bf16(PAF(0),VFR(4),o[1],0,0,0), C0,4); \
    KRD(GL,0); GAPB(o[0]=__builtin_amdgcn_mfma_f32_32x32x16_bf16(PAF(1),VFR(1),o[0],0,0,0), C0,8); \
    KRD(GL,1); GAPB(o[1]=__builtin_amdgcn_mfma_f32_32x32x16_bf16(PAF(1),VFR(5),o[1],0,0,0), C0,12); \
    KRD(GL,2); GAPB(o[0]=__builtin_amdgcn_mfma_f32_32x32x16_bf16(PAF(2),VFR(2),o[0],0,0,0), C1,0); \
    KRD(GL,3); GAPB(o[1]=__builtin_amdgcn_mfma_f32_32x32x16_bf16(PAF(2),VFR(6),o[1],0,0,0), C1,4); \
    GAPB(o[0]=__builtin_amdgcn_mfma_f32_32x32x16_bf16(PAF(3),VFR(3),o[0],0,0,0), C1,8); \
    GAPB(o[1]=__builtin_amdgcn_mfma_f32_32x32x16_bf16(PAF(3),VFR(7),o[1],0,0,0), C1,12); \
    }while(0)
  int t=1;
  #undef CMASK
  #define CMASK(P0,P1,t) do{}while(0)
  for(;t+5<NT;t+=2){
    STEP(pB0,pB1,pA0,pA1,t,true,true,true);     WAIT_BAR(2); RESC(); ROT();
    STEP(pA0,pA1,pB0,pB1,t+1,true,true,true);   WAIT_BAR(2); RESC(); ROT();
  }
  #undef CMASK
  #define CMASK(P0,P1,t) do{int jb_=(t)-(NT-4); if(jb_>=0)cmask(P0,P1,jb_,qrel,hi);}while(0)
  #define ENDW(tt) do{ if((tt)+3<NT){WAIT_BAR(2);} else if((tt)+2<NT){WAIT_BAR(1);} else {WAIT_BAR(0);} }while(0)
  for(;t+1<NT;t+=2){
    STEP(pB0,pB1,pA0,pA1,t,(t+3<NT),(t+1<NT),(t+1<NT));       ENDW(t);   RESC(); ROT();
    STEP(pA0,pA1,pB0,pB1,t+1,(t+4<NT),(t+2<NT),(t+2<NT));     ENDW(t+1); RESC(); ROT();
  }
  STEP(pB0,pB1,pA0,pA1,NT-1,false,false,false); RESC();
  { float sacc=pB0[0]+pB0[1]; _Pragma("unroll") for(int r=2;r<16;++r)sacc+=pB0[r]; _Pragma("unroll") for(int r=0;r<16;++r)sacc+=pB1[r]; l_reg+=sacc;
    pw0=(u32x4){PKW(pB0,0),PKW(pB0,2),PKW(pB0,4),PKW(pB0,6)};pw1=(u32x4){PKW(pB0,8),PKW(pB0,10),PKW(pB0,12),PKW(pB0,14)};pw2=(u32x4){PKW(pB1,0),PKW(pB1,2),PKW(pB1,4),PKW(pB1,6)};pw3=(u32x4){PKW(pB1,8),PKW(pB1,10),PKW(pB1,12),PKW(pB1,14)};
    SBAR(); pv(o,vb0+sl_cur,PAF(0),PAF(1),PAF(2),PAF(3)); }
  #undef PKW
  #undef PAF
  #undef VFR
  #undef PIN
  #undef MX3
  #undef GAPA
  #undef GAPB
  #undef EX
  #undef VRD
  #undef KRD
  #undef STEP
  #undef ENDW
  {auto rr=__builtin_amdgcn_permlane32_swap(__float_as_uint(l_reg),__float_as_uint(l_reg),false,false);l_reg=__uint_as_float(rr[0])+__uint_as_float(rr[1]);}
  if(hi==0)wsf[32+r32]=l_reg;asm volatile("s_waitcnt lgkmcnt(0)":::"memory");
  float rli[16];
  #pragma unroll
  for(int r=0;r<16;++r)rli[r]=__builtin_amdgcn_rcpf(wsf[32+crow(r,hi)]);
  bf16*Ow=O+(rowbase+q0+wid*QBLK)*DM+h*D;
  { bf16*stg=(bf16*)(shm+LDS_OST)+wid*2048;
    #pragma unroll
    for(int r=0;r<16;++r){const int orow=crow(r,hi);
      #pragma unroll
      for(int d0=0;d0<2;++d0)stg[orow*64+d0*32+r32]=__float2bfloat16(o[d0][r]*rli[r]);}
    asm volatile("s_waitcnt lgkmcnt(0)":::"memory");
    #pragma unroll
    for(int i=0;i<4;++i){const int row=i*8+(lane>>3),ch=lane&7; const u32x4 v=*(const u32x4*)(stg+row*64+ch*8); ATTN_STORE16(Ow+(long)row*DM+ch*8,v);} }
  asm volatile("s_waitcnt lgkmcnt(0)\n\ts_barrier":::"memory");
  #undef KBIAS
  #undef MKQX
  #undef DMA_K
  #undef DMA_V
  #undef CMASK
  #undef START
  #undef RESC
  #undef ROT
}
constexpr int ATTN_LDS_BYTES=LDS_BYTES;
struct AttnTensors { const bf16* Q; const bf16* K; const bf16* V; bf16* O; };
struct AttnUnit { int bh; int qb; };
struct StaticOrder {
  int G,c;
  __device__ __forceinline__ StaticOrder(int grid,int block):G(grid),c(block){}
  __device__ __forceinline__ bool next(int i,AttnUnit&u)const{ const int j=i*G+((i&1)?(G-1-c):c); if(j>=NHEAD*NQB)return false; u.bh=j%NHEAD; u.qb=NQB-1-j/NHEAD; return true; }
  __device__ __forceinline__ void a_ready(const AttnUnit&)const{}
  __device__ __forceinline__ void done(const AttnUnit&)const{}
};
template<class Sched,int THRL=8> __device__ __forceinline__ void attn_phase(char*lds,const AttnTensors&T,const Sched&S,const float*cb){
  AttnUnit u;
  for(int i=0;S.next(i,u);++i){ S.a_ready(u); attn_unit<THRL>(u.bh/NHEAD,u.bh%NHEAD,u.qb,T.Q,T.K,T.V,T.O,lds,cb+(long)(u.bh%NHEAD)*SEQ); S.done(u); }
}
#undef SBAR
#undef WAIT_BAR
}
#define LAS __attribute__((address_space(3)))
typedef unsigned short bf16_t;
typedef short bf16x8 __attribute__((ext_vector_type(8)));
typedef short s16x4 __attribute__((ext_vector_type(4)));
typedef float f32x4 __attribute__((ext_vector_type(4)));
typedef unsigned u32x4 __attribute__((ext_vector_type(4)));
typedef unsigned u32x2 __attribute__((ext_vector_type(2)));

constexpr int MP = 16384, MS = 512, M = MP + MS, DM = 1024;
constexpr int DI = 2048, CONVD = 3072, NIN = 5152, NIN_PAD = 5376, NHM = 32;
constexpr int DFF = 2816, NUP = 5632, NQ = 3328, NH = 16;
constexpr int NSB = 32, SL = 16, PAST = 1024, KL = PAST + SL;
constexpr float EPS = 1e-6f, LOG2E = 1.4426950408889634f, C2Q = 0.125f * 1.4426950408889634f;
constexpr int NCH = MP / 64;
constexpr size_t O_Y = 0, O_PSSM = (size_t)M * DM, O_PMC = O_PSSM + 32 * 64 * 128, O_PFC = O_PMC + 3 * CONVD, O_PK = O_PFC + 2 * 2 * NUP,
                 O_PV = O_PK + (size_t)MP * DM, O_PLF = O_PV + (size_t)MP * DM, O_SSSM = O_PLF + (size_t)MP * NH, O_SMC = O_SSSM + (size_t)NSB * 32 * 64 * 128,
                 O_SFC = O_SMC + (size_t)NSB * 3 * CONVD, O_SK = O_SFC + (size_t)2 * NSB * 2 * NUP, O_SV = O_SK + (size_t)MS * DM, O_SLF = O_SV + (size_t)MS * DM,
                 O_END = O_SLF + (size_t)MS * NH;
constexpr size_t al(size_t x) { return (x + 255) & ~(size_t)255; }
constexpr size_t WS_SSQ = 0;
constexpr size_t WS_DT = WS_SSQ + al((size_t)4 * M * 16 * 4);
constexpr size_t WS_DEC = WS_DT + al((size_t)M * 32 * 4);
constexpr size_t WS_CB = WS_DEC + al((size_t)NCH * 32 * 4);
constexpr size_t WS_CS = WS_CB + al((size_t)NH * MP * 4);
constexpr size_t WS_WIN = WS_CS + al((size_t)NSB * NH * KL * 4);
constexpr size_t WS_WOUT = WS_WIN + al((size_t)NIN_PAD * DM * 2);
constexpr size_t WS_WUP = WS_WOUT + al((size_t)DM * DI * 2);
constexpr size_t WS_WDN = WS_WUP + al((size_t)2 * NUP * DM * 2);
constexpr size_t WS_WQ = WS_WDN + al((size_t)2 * DM * DFF * 2);
constexpr size_t WS_WO = WS_WQ + al((size_t)NQ * DM * 2);
constexpr size_t WS_HB = WS_WO + al((size_t)DM * DM * 2);
constexpr size_t WS_S0 = WS_HB + al((size_t)M * DM * 2);
constexpr size_t WS_ZB = WS_S0;
constexpr size_t WS_X1 = WS_ZB + al((size_t)M * DI * 2);
constexpr size_t WS_X2 = WS_X1 + al((size_t)M * CONVD * 2);
constexpr size_t WS_ST = WS_X2 + al((size_t)M * CONVD * 2);
constexpr size_t WS_END1 = WS_ST + al((size_t)NCH * 32 * 8192 * 2);
constexpr size_t WS_UP = WS_S0;
constexpr size_t WS_G = WS_UP + al((size_t)M * NUP * 2);
constexpr size_t WS_QB = WS_G + al((size_t)M * DFF * 2);
constexpr size_t WS_KB = WS_QB + al((size_t)M * DM * 2);
constexpr size_t WS_VB = WS_KB + al((size_t)M * DM * 2);
constexpr size_t WS_END2 = WS_VB + al((size_t)M * DM * 2);
constexpr size_t WS_NEED = WS_END1 > WS_END2 ? WS_END1 : WS_END2;

constexpr int NT_ = 512, NW_ = 8;
constexpr int LDS_TOTAL = 151552;

struct Args { const float* in[30]; float* out; unsigned char* ws; int ph_lo, ph_hi; };

__device__ __forceinline__ unsigned f2bf(float f) { unsigned u = __builtin_bit_cast(unsigned, f); return (u + 0x7fffu + ((u >> 16) & 1u)) >> 16; }
__device__ __forceinline__ unsigned pk2(float lo, float hi) { typedef float f2 __attribute__((ext_vector_type(2))); typedef __bf16 b2 __attribute__((ext_vector_type(2))); f2 v = {lo, hi}; b2 b = __builtin_convertvector(v, b2); return __builtin_bit_cast(unsigned, b); }
__device__ __forceinline__ float bflo(unsigned u) { return __uint_as_float(u << 16); }
__device__ __forceinline__ float bfhi(unsigned u) { return __uint_as_float(u & 0xffff0000u); }
__device__ __forceinline__ float bf1(bf16_t u) { return __uint_as_float((unsigned)u << 16); }
__device__ __forceinline__ void unpack8(u32x4 v, float* f) { f[0] = bflo(v.x); f[1] = bfhi(v.x); f[2] = bflo(v.y); f[3] = bfhi(v.y); f[4] = bflo(v.z); f[5] = bfhi(v.z); f[6] = bflo(v.w); f[7] = bfhi(v.w); }
__device__ __forceinline__ u32x4 pack8(const float* f) { u32x4 o; o.x = pk2(f[0], f[1]); o.y = pk2(f[2], f[3]); o.z = pk2(f[4], f[5]); o.w = pk2(f[6], f[7]); return o; }
__device__ __forceinline__ float wave_sum(float v) {
#pragma unroll
    for (int o = 1; o < 64; o <<= 1) v += __shfl_xor(v, o);
    return v; }
__device__ __forceinline__ float wave_max(float v) {
#pragma unroll
    for (int o = 1; o < 64; o <<= 1) v = fmaxf(v, __shfl_xor(v, o));
    return v; }
__device__ __forceinline__ float wave_incl_scan(float v, int lane) {
#pragma unroll
    for (int o = 1; o < 64; o <<= 1) { const float t = __shfl_up(v, o); if (lane >= o) v += t; }
    return v; }
__device__ __forceinline__ float silu(float x) { return x / (1.f + __expf(-x)); }
__device__ __forceinline__ float row_rs(const float* ssq, int row) {
    const f32x4* p = (const f32x4*)(ssq + (size_t)row * 16); const f32x4 a = p[0], b = p[1], c = p[2], d = p[3];
    const float s = ((a.x + a.y) + (a.z + a.w)) + ((b.x + b.y) + (b.z + b.w)) + ((c.x + c.y) + (c.z + c.w)) + ((d.x + d.y) + (d.z + d.w));
    return rsqrtf(s * (1.f / DM) + EPS); }

using pg8::Unit;
struct EpiIn {
    static constexpr bool PERM = true, AFTER_DRAIN = false;
    const float* ssq; bf16_t* zb; bf16_t* x1; float* dtr;
    __device__ __forceinline__ void operator()(const f32x4 (&acc)[2][2][4][2], const Unit& u, int wr, int wc, int fr, int fq) const {
#pragma unroll
        for (int ai = 0; ai < 2; ++ai)
#pragma unroll
            for (int m = 0; m < 4; ++m) { const int row = u.pm * 256 + ai * 128 + wr * 64 + m * 16 + fr; const float rs = row_rs(ssq, row);
#pragma unroll
                for (int bj = 0; bj < 2; ++bj) { const int col = u.pn * 256 + bj * 128 + wc * 32 + 8 * fq; const f32x4 v0 = acc[ai][bj][m][0] * rs, v1 = acc[ai][bj][m][1] * rs;
                    u32x4 w; w.x = pk2(v0[0], v0[1]); w.y = pk2(v0[2], v0[3]); w.z = pk2(v1[0], v1[1]); w.w = pk2(v1[2], v1[3]);
                    if (u.pn < 8) *(u32x4*)(zb + (size_t)row * DI + col) = w;
                    else if (u.pn < 20) *(u32x4*)(x1 + (size_t)row * CONVD + (col - DI)) = w;
                    else if (col < NIN) { float* d = dtr + (size_t)row * 32 + (col - DI - CONVD); *(f32x4*)d = v0; *(f32x4*)(d + 4) = v1; } } }
    }
};
struct EpiRes {
    static constexpr bool PERM = true, AFTER_DRAIN = false;
    float* hf; bf16_t* hb; float* ssq;
    __device__ __forceinline__ void operator()(const f32x4 (&acc)[2][2][4][2], const Unit& u, int wr, int wc, int fr, int fq) const {
#pragma unroll
        for (int ai = 0; ai < 2; ++ai)
#pragma unroll
            for (int m = 0; m < 4; ++m) { const int row = u.pm * 256 + ai * 128 + wr * 64 + m * 16 + fr; float sq = 0.f;
#pragma unroll
                for (int bj = 0; bj < 2; ++bj) { const int col = u.pn * 256 + bj * 128 + wc * 32 + 8 * fq; float* hp = hf + (size_t)row * DM + col;
                    const f32x4 v0 = *(const f32x4*)hp + acc[ai][bj][m][0], v1 = *(const f32x4*)(hp + 4) + acc[ai][bj][m][1];
                    *(f32x4*)hp = v0; *(f32x4*)(hp + 4) = v1;
                    u32x4 w; w.x = pk2(v0[0], v0[1]); w.y = pk2(v0[2], v0[3]); w.z = pk2(v1[0], v1[1]); w.w = pk2(v1[2], v1[3]);
                    *(u32x4*)(hb + (size_t)row * DM + col) = w;
                    sq += (v0[0] * v0[0] + v0[1] * v0[1]) + (v0[2] * v0[2] + v0[3] * v0[3]) + (v1[0] * v1[0] + v1[1] * v1[1]) + (v1[2] * v1[2] + v1[3] * v1[3]); }
                sq += __shfl_xor(sq, 16); sq += __shfl_xor(sq, 32);
                if (fq == 0) ssq[(size_t)row * 16 + u.pn * 4 + wc] = sq; }
    }
};
struct EpiUp {
    static constexpr bool PERM = true, AFTER_DRAIN = false;
    const float* ssq; bf16_t* up;
    __device__ __forceinline__ void operator()(const f32x4 (&acc)[2][2][4][2], const Unit& u, int wr, int wc, int fr, int fq) const {
#pragma unroll
        for (int ai = 0; ai < 2; ++ai)
#pragma unroll
            for (int m = 0; m < 4; ++m) { const int row = u.pm * 256 + ai * 128 + wr * 64 + m * 16 + fr; const float rs = row_rs(ssq, row);
#pragma unroll
                for (int bj = 0; bj < 2; ++bj) { const int col = u.pn * 256 + bj * 128 + wc * 32 + 8 * fq; const f32x4 v0 = acc[ai][bj][m][0] * rs, v1 = acc[ai][bj][m][1] * rs;
                    u32x4 w; w.x = pk2(v0[0], v0[1]); w.y = pk2(v0[2], v0[3]); w.z = pk2(v1[0], v1[1]); w.w = pk2(v1[2], v1[3]);
                    *(u32x4*)(up + (size_t)row * NUP + col) = w; } }
    }
};
struct EpiQkv {
    static constexpr bool PERM = true, AFTER_DRAIN = false;
    const float* ssq; bf16_t* qb; bf16_t* kb; bf16_t* vb; float* out; const float* bfv;
    __device__ __forceinline__ void operator()(const f32x4 (&acc)[2][2][4][2], const Unit& u, int wr, int wc, int fr, int fq) const {
        const int sec = u.pn >> 2;
#pragma unroll
        for (int ai = 0; ai < 2; ++ai)
#pragma unroll
            for (int m = 0; m < 4; ++m) { const int row = u.pm * 256 + ai * 128 + wr * 64 + m * 16 + fr; float rs = row_rs(ssq, row); if (sec == 0) rs *= C2Q;
#pragma unroll
                for (int bj = 0; bj < 2; ++bj) { const int col = (u.pn & 3) * 256 + bj * 128 + wc * 32 + 8 * fq; const f32x4 v0 = acc[ai][bj][m][0] * rs, v1 = acc[ai][bj][m][1] * rs;
                    u32x4 w; w.x = pk2(v0[0], v0[1]); w.y = pk2(v0[2], v0[3]); w.z = pk2(v1[0], v1[1]); w.w = pk2(v1[2], v1[3]);
                    if (sec == 0) *(u32x4*)(qb + (size_t)row * DM + col) = w;
                    else if (sec < 3) { *(u32x4*)((sec == 1 ? kb : vb) + (size_t)row * DM + col) = w;
                        float* o = (row < MP) ? out + (sec == 1 ? O_PK : O_PV) + (size_t)row * DM + col : out + (sec == 1 ? O_SK : O_SV) + (size_t)(row - MP) * DM + col;
                        *(f32x4*)o = v0; *(f32x4*)(o + 4) = v1; }
                    else if (col < NH) { float* o = (row < MP) ? out + O_PLF + (size_t)row * NH + col : out + O_SLF + (size_t)(row - MP) * NH + col;
                        float r[8] = {v0[0], v0[1], v0[2], v0[3], v1[0], v1[1], v1[2], v1[3]};
#pragma unroll
                        for (int e = 0; e < 8; ++e) { const float x = r[e] + bfv[col + e]; r[e] = fminf(x, 0.f) - log1pf(__expf(-fabsf(x))); }
                        *(f32x4*)o = (f32x4){r[0], r[1], r[2], r[3]}; *(f32x4*)(o + 4) = (f32x4){r[4], r[5], r[6], r[7]}; } } }
    }
};
struct Ctx { LAS unsigned char* lds; int tid, lane, wave, G, bid; const float* const* in; float* out; unsigned char* ws; };

__device__ __forceinline__ void p0_transpose_item(const float* W, const float* nw, int K, int N, bf16_t* WT, int row_off, LAS float* scr, int item, int lane) {
    const int nblk = N / 32, kb = item / nblk, nb = item % nblk, k0 = 64 * kb, n0 = 32 * nb;
#pragma unroll 8
    for (int i = 0; i < 32; ++i) { const int kk = 2 * i + (lane >> 5); const float s = nw ? nw[k0 + kk] : 1.f; scr[kk * 33 + (lane & 31)] = W[(size_t)(k0 + kk) * N + n0 + (lane & 31)] * s; }
    asm volatile("s_waitcnt lgkmcnt(0)" ::: "memory");
    const int c = lane & 7;
#pragma unroll
    for (int j = 0; j < 4; ++j) { const int n = (lane >> 3) + 8 * j; const LAS float* s = scr + (8 * c) * 33 + n;
        u32x4 o; o.x = pk2(s[0 * 33], s[1 * 33]); o.y = pk2(s[2 * 33], s[3 * 33]); o.z = pk2(s[4 * 33], s[5 * 33]); o.w = pk2(s[6 * 33], s[7 * 33]);
        *(u32x4*)(WT + (size_t)(row_off + n0 + n) * K + k0 + 8 * c) = o; }
    asm volatile("s_waitcnt lgkmcnt(0)" ::: "memory");
}
__device__ __forceinline__ void phase_prologue(const Ctx& C) {
    LAS float* scr = (LAS float*)(C.lds + C.wave * 16384);
    const int gw = C.bid * NW_ + C.wave, NGW = C.G * NW_;
    unsigned char* ws = C.ws;
    bf16_t* Win = (bf16_t*)(ws + WS_WIN); bf16_t* Wout = (bf16_t*)(ws + WS_WOUT); bf16_t* Wup = (bf16_t*)(ws + WS_WUP); bf16_t* Wdn = (bf16_t*)(ws + WS_WDN);
    bf16_t* Wq = (bf16_t*)(ws + WS_WQ); bf16_t* Wo = (bf16_t*)(ws + WS_WO);
    constexpr int I_IN = (DM / 64) * (NIN / 32), I_OUT = (DI / 64) * (DM / 32), I_UP = (DM / 64) * (NUP / 32), I_DN = (DFF / 64) * (DM / 32), I_SQ = (DM / 64) * (DM / 32);
    constexpr int NITEMS = I_IN + I_OUT + 2 * I_UP + 2 * I_DN + 4 * I_SQ;
    for (int it = gw; it < NITEMS; it += NGW) {
        int r = it;
        if (r < I_IN) { p0_transpose_item(C.in[10], C.in[8], DM, NIN, Win, 0, scr, r, C.lane); continue; } r -= I_IN;
        if (r < I_OUT) { p0_transpose_item(C.in[17], nullptr, DI, DM, Wout, 0, scr, r, C.lane); continue; } r -= I_OUT;
        if (r < I_UP) { p0_transpose_item(C.in[25], C.in[9], DM, NUP, Wup, 0, scr, r, C.lane); continue; } r -= I_UP;
        if (r < I_UP) { p0_transpose_item(C.in[25] + (size_t)DM * NUP, C.in[9] + DM, DM, NUP, Wup + (size_t)NUP * DM, 0, scr, r, C.lane); continue; } r -= I_UP;
        if (r < I_DN) { p0_transpose_item(C.in[28], nullptr, DFF, DM, Wdn, 0, scr, r, C.lane); continue; } r -= I_DN;
        if (r < I_DN) { p0_transpose_item(C.in[28] + (size_t)DFF * DM, nullptr, DFF, DM, Wdn + (size_t)DM * DFF, 0, scr, r, C.lane); continue; } r -= I_DN;
        if (r < I_SQ) { p0_transpose_item(C.in[23], C.in[8] + DM, DM, DM, Wq, 0, scr, r, C.lane); continue; } r -= I_SQ;
        if (r < I_SQ) { p0_transpose_item(C.in[19], C.in[18], DM, DM, Wq, DM, scr, r, C.lane); continue; } r -= I_SQ;
        if (r < I_SQ) { p0_transpose_item(C.in[20], C.in[18], DM, DM, Wq, 2 * DM, scr, r, C.lane); continue; } r -= I_SQ;
        p0_transpose_item(C.in[24], nullptr, DM, DM, Wo, 0, scr, r, C.lane);
    }
    const int gt = C.bid * NT_ + C.tid, NGT = C.G * NT_;
    for (int i = gt; i < 16 * DM; i += NGT) { const int n = i / DM, k = i % DM; Wq[(size_t)(3 * DM + n) * DM + k] = (bf16_t)f2bf(C.in[21][(size_t)k * 16 + n] * C.in[18][k]); }
    for (int i = gt; i < (NQ - 3 * DM - 16) * DM / 8; i += NGT) ((u32x4*)(Wq + (size_t)(3 * DM + 16) * DM))[i] = (u32x4){0u, 0u, 0u, 0u};
    for (int i = gt; i < (NIN_PAD - NIN) * DM / 8; i += NGT) ((u32x4*)(Win + (size_t)NIN * DM))[i] = (u32x4){0u, 0u, 0u, 0u};
    float* ssq0 = (float*)(ws + WS_SSQ); bf16_t* hb = (bf16_t*)(ws + WS_HB);
    for (int m = gw; m < M; m += NGW) {
        const float* xr = (m < MP) ? C.in[0] + (size_t)m * DM : C.in[1] + (size_t)(m - MP) * DM;
        float s = 0.f;
#pragma unroll
        for (int j = 0; j < 4; ++j) { const f32x4 v = ((const f32x4*)xr)[C.lane + 64 * j]; s += (v.x * v.x + v.y * v.y) + (v.z * v.z + v.w * v.w);
            ((f32x4*)(C.out + (size_t)m * DM))[C.lane + 64 * j] = v; ((u32x2*)(hb + (size_t)m * DM))[C.lane + 64 * j] = (u32x2){pk2(v.x, v.y), pk2(v.z, v.w)}; }
        s = wave_sum(s);
        if (C.lane < 16) ssq0[(size_t)m * 16 + C.lane] = (C.lane == 0) ? s : 0.f;
    }
}

__device__ __forceinline__ void phase_mconv(const Ctx& C) {
    const bf16_t* x1 = (const bf16_t*)(C.ws + WS_X1); bf16_t* x2 = (bf16_t*)(C.ws + WS_X2); float* dt = (float*)(C.ws + WS_DT);
    const float* cw = C.in[11]; const float* cbias = C.in[12]; const float* st = C.in[3];
    const int gt = C.bid * NT_ + C.tid, NGT = C.G * NT_;
    constexpr int NCG = CONVD / 8, NRB = M / 16;
    for (int it = gt; it < NRB * NCG; it += NGT) {
        const int rb = it / NCG, c0 = (it % NCG) * 8, m0 = rb * 16;
        float w[4][8], bb[8], h0[8], h1[8], h2[8];
#pragma unroll
        for (int t = 0; t < 4; ++t) { const f32x4 a = *(const f32x4*)(cw + t * CONVD + c0), b = *(const f32x4*)(cw + t * CONVD + c0 + 4); w[t][0] = a.x; w[t][1] = a.y; w[t][2] = a.z; w[t][3] = a.w; w[t][4] = b.x; w[t][5] = b.y; w[t][6] = b.z; w[t][7] = b.w; }
        { const f32x4 a = *(const f32x4*)(cbias + c0), b = *(const f32x4*)(cbias + c0 + 4); bb[0] = a.x; bb[1] = a.y; bb[2] = a.z; bb[3] = a.w; bb[4] = b.x; bb[5] = b.y; bb[6] = b.z; bb[7] = b.w; }
        if (rb >= MP / 16) { const float* sp = st + (size_t)(rb - MP / 16) * 3 * CONVD + c0;
#pragma unroll
            for (int e = 0; e < 8; ++e) { h0[e] = sp[e]; h1[e] = sp[CONVD + e]; h2[e] = sp[2 * CONVD + e]; } }
        else if (rb == 0) {
#pragma unroll
            for (int e = 0; e < 8; ++e) { h0[e] = 0.f; h1[e] = 0.f; h2[e] = 0.f; } }
        else { unpack8(*(const u32x4*)(x1 + (size_t)(m0 - 3) * CONVD + c0), h0); unpack8(*(const u32x4*)(x1 + (size_t)(m0 - 2) * CONVD + c0), h1); unpack8(*(const u32x4*)(x1 + (size_t)(m0 - 1) * CONVD + c0), h2); }
#pragma unroll 4
        for (int i = 0; i < 16; ++i) { float cur[8], o[8]; unpack8(*(const u32x4*)(x1 + (size_t)(m0 + i) * CONVD + c0), cur);
#pragma unroll
            for (int e = 0; e < 8; ++e) { const float v = bb[e] + w[0][e] * h0[e] + w[1][e] * h1[e] + w[2][e] * h2[e] + w[3][e] * cur[e]; o[e] = silu(v); h0[e] = h1[e]; h1[e] = h2[e]; h2[e] = cur[e]; }
            *(u32x4*)(x2 + (size_t)(m0 + i) * CONVD + c0) = pack8(o); }
    }
    const float* dtb = C.in[13];
    for (int i = gt; i < M * 32; i += NGT) { const float x = dt[i] + dtb[i & 31]; dt[i] = x > 20.f ? x : log1pf(__expf(x)); }
    for (int i = gt; i < 33 * 3 * CONVD; i += NGT) { const int sq = i / (3 * CONVD), r = i % (3 * CONVD), j = r / CONVD, c = r % CONVD;
        if (sq == 0) C.out[O_PMC + r] = bf1(x1[(size_t)(MP - 3 + j) * CONVD + c]);
        else C.out[O_SMC + (size_t)(sq - 1) * 3 * CONVD + r] = bf1(x1[(size_t)(MP + (sq - 1) * 16 + 13 + j) * CONVD + c]); }
}

__device__ __forceinline__ void phase_fconv(const Ctx& C, int layer) {
    const bf16_t* up = (const bf16_t*)(C.ws + WS_UP); bf16_t* g = (bf16_t*)(C.ws + WS_G);
    const float* cw = C.in[26] + (size_t)layer * 3 * NUP; const float* cbias = C.in[27] + (size_t)layer * NUP; const float* st = C.in[4] + (size_t)layer * NSB * 2 * NUP;
    const int gt = C.bid * NT_ + C.tid, NGT = C.G * NT_;
    constexpr int NCG = DFF / 8, NRB = M / 8;
    for (int it = gt; it < NRB * NCG; it += NGT) {
        const int rb = it / NCG, c0 = (it % NCG) * 8, m0 = rb * 8;
        const bool sstart = (m0 >= MP) && (((m0 - MP) & 15) == 0);
        float o[8][8];
#pragma unroll
        for (int half = 0; half < 2; ++half) {
            const int cc = c0 + half * DFF;
            float w[3][8], bb[8], h0[8], h1[8];
#pragma unroll
            for (int t = 0; t < 3; ++t) { const f32x4 a = *(const f32x4*)(cw + t * NUP + cc), b = *(const f32x4*)(cw + t * NUP + cc + 4); w[t][0] = a.x; w[t][1] = a.y; w[t][2] = a.z; w[t][3] = a.w; w[t][4] = b.x; w[t][5] = b.y; w[t][6] = b.z; w[t][7] = b.w; }
            { const f32x4 a = *(const f32x4*)(cbias + cc), b = *(const f32x4*)(cbias + cc + 4); bb[0] = a.x; bb[1] = a.y; bb[2] = a.z; bb[3] = a.w; bb[4] = b.x; bb[5] = b.y; bb[6] = b.z; bb[7] = b.w; }
            if (sstart) { const float* sp = st + (size_t)((m0 - MP) >> 4) * 2 * NUP + cc;
#pragma unroll
                for (int e = 0; e < 8; ++e) { h0[e] = sp[e]; h1[e] = sp[NUP + e]; } }
            else if (m0 == 0) {
#pragma unroll
                for (int e = 0; e < 8; ++e) { h0[e] = 0.f; h1[e] = 0.f; } }
            else { unpack8(*(const u32x4*)(up + (size_t)(m0 - 2) * NUP + cc), h0); unpack8(*(const u32x4*)(up + (size_t)(m0 - 1) * NUP + cc), h1); }
#pragma unroll
            for (int i = 0; i < 8; ++i) { float cur[8]; unpack8(*(const u32x4*)(up + (size_t)(m0 + i) * NUP + cc), cur);
#pragma unroll
                for (int e = 0; e < 8; ++e) { const float v = bb[e] + w[0][e] * h0[e] + w[1][e] * h1[e] + w[2][e] * cur[e]; o[i][e] = half == 0 ? silu(v) : o[i][e] * v; h0[e] = h1[e]; h1[e] = cur[e]; } }
        }
#pragma unroll
        for (int i = 0; i < 8; ++i) *(u32x4*)(g + (size_t)(m0 + i) * DFF + c0) = pack8(o[i]);
    }
    for (int i = gt; i < 33 * 2 * NUP; i += NGT) { const int sq = i / (2 * NUP), r = i % (2 * NUP), j = r / NUP, c = r % NUP;
        if (sq == 0) C.out[O_PFC + (size_t)layer * 2 * NUP + r] = bf1(up[(size_t)(MP - 2 + j) * NUP + c]);
        else C.out[O_SFC + ((size_t)layer * NSB + (sq - 1)) * 2 * NUP + r] = bf1(up[(size_t)(MP + (sq - 1) * 16 + 14 + j) * NUP + c]); }
}

__device__ __forceinline__ void phase_final(const Ctx& C) {
    const int gw = C.bid * NW_ + C.wave, NGW = C.G * NW_; const float* fw = C.in[29];
    for (int m = gw; m < M; m += NGW) { f32x4* r = (f32x4*)(C.out + (size_t)m * DM); f32x4 v[4]; float s = 0.f;
#pragma unroll
        for (int j = 0; j < 4; ++j) { v[j] = r[C.lane + 64 * j]; s += (v[j].x * v[j].x + v[j].y * v[j].y) + (v[j].z * v[j].z + v[j].w * v[j].w); }
        const float rs = rsqrtf(wave_sum(s) * (1.f / DM) + EPS);
#pragma unroll
        for (int j = 0; j < 4; ++j) r[C.lane + 64 * j] = v[j] * rs * ((const f32x4*)fw)[C.lane + 64 * j]; }
}
typedef short v4i16_t __attribute__((ext_vector_type(4)));
__device__ __forceinline__ s16x4 vtr(const LAS unsigned char* p) { return __builtin_bit_cast(s16x4, __builtin_amdgcn_ds_read_tr16_b64_v4i16((LAS v4i16_t*)p)); }
__device__ __forceinline__ bf16x8 trfrag(const LAS unsigned char* img, int rs, int k0, int c0, int lane) {
    const int gq = lane >> 4, li = lane & 15, q = li >> 2, p = li & 3;
    const LAS unsigned char* a = img + (k0 + 8 * gq + q) * rs + (c0 + 4 * p) * 2;
    const s16x4 r1 = vtr(a), r2 = vtr(a + 4 * rs);
    return (bf16x8){r1[0], r1[1], r1[2], r1[3], r2[0], r2[1], r2[2], r2[3]};
}
constexpr int RSB = 272, RSX = 144;
constexpr int SSD_UNITS = (NCH + NSB) * 4;
__device__ __forceinline__ void ssd_unit_geom(int unit, int& uc, int& g, int& m0, int& L) { uc = unit >> 2; g = unit & 3; if (uc < NCH) { m0 = 64 * uc; L = 64; } else { m0 = MP + 16 * (uc - NCH); L = 16; } }
__device__ __forceinline__ void ssd_load_tile128(const Ctx& C, LAS unsigned char* dst, const bf16_t* x2, int m0, int L, int col0) {
    const int row = C.tid >> 3;
#pragma unroll
    for (int cc = 0; cc < 2; ++cc) { const int ch = (C.tid & 7) * 2 + cc; u32x4 v = {0u, 0u, 0u, 0u};
        if (row < L) v = *(const u32x4*)(x2 + (size_t)(m0 + row) * CONVD + col0 + 8 * ch);
        *(LAS u32x4*)(dst + row * RSB + 16 * ch) = v; }
}

__device__ __forceinline__ void phase_ssd1(const Ctx& C) {
    const bf16_t* x2 = (const bf16_t*)(C.ws + WS_X2); const float* dt = (const float*)(C.ws + WS_DT); bf16_t* st = (bf16_t*)(C.ws + WS_ST); float* dec = (float*)(C.ws + WS_DEC);
    LAS unsigned char* Bs = C.lds; LAS unsigned char* Xs = C.lds + 17408 + C.wave * 9728; LAS float* sc = (LAS float*)(Xs + 9216);
    const int lane = C.lane, gq = lane >> 4, li = lane & 15;
    for (int unit = C.bid; unit < SSD_UNITS; unit += C.G) {
        int uc, g, m0, L; ssd_unit_geom(unit, uc, g, m0, L);
        const int h = 8 * g + C.wave;
        ssd_load_tile128(C, Bs, x2, m0, L, DI + 128 * g);
        const float Ah = -__expf(C.in[14][h]);
        const float dtv = (lane < L) ? dt[(size_t)(m0 + lane) * 32 + h] : 0.f;
        const float acum = wave_incl_scan(dtv * Ah, lane); const float last = __shfl(acum, 63);
        sc[lane] = dtv * __expf(last - acum);
        asm volatile("s_waitcnt lgkmcnt(0)" ::: "memory");
#pragma unroll
        for (int i = 0; i < 8; ++i) { const int srow = 8 * i + (lane >> 3), pc = lane & 7; u32x4 v = {0u, 0u, 0u, 0u};
            if (srow < L) v = *(const u32x4*)(x2 + (size_t)(m0 + srow) * CONVD + 64 * h + 8 * pc);
            float f[8]; unpack8(v, f); const float s = sc[srow];
#pragma unroll
            for (int e = 0; e < 8; ++e) f[e] *= s;
            *(LAS u32x4*)(Xs + srow * RSX + 16 * pc) = pack8(f); }
        __syncthreads();
        bf16x8 xf[2][4];
#pragma unroll
        for (int ks = 0; ks < 2; ++ks)
#pragma unroll
            for (int pt = 0; pt < 4; ++pt) xf[ks][pt] = trfrag(Xs, RSX, 32 * ks, 16 * pt, lane);
        const float elast = __expf(last);
#pragma unroll 1
        for (int nt = 0; nt < 8; ++nt) {
            f32x4 acc[4];
#pragma unroll
            for (int pt = 0; pt < 4; ++pt) acc[pt] = (f32x4){0.f, 0.f, 0.f, 0.f};
#pragma unroll
            for (int ks = 0; ks < 2; ++ks) { const bf16x8 af = trfrag(Bs, RSB, 32 * ks, 16 * nt, lane);
#pragma unroll
                for (int pt = 0; pt < 4; ++pt) acc[pt] = __builtin_amdgcn_mfma_f32_16x16x32_bf16(af, xf[ks][pt], acc[pt], 0, 0, 0); }
#pragma unroll
            for (int pt = 0; pt < 4; ++pt) { const int p_ = 16 * pt + li, n0 = 16 * nt + 4 * gq;
                if (uc < NCH) { *(u32x2*)(st + ((size_t)(uc * 32 + h) * 64 + p_) * 128 + n0) = (u32x2){pk2(acc[pt][0], acc[pt][1]), pk2(acc[pt][2], acc[pt][3])}; }
                else { const size_t idx = ((size_t)((uc - NCH) * 32 + h) * 64 + p_) * 128 + n0; const f32x4 h0 = *(const f32x4*)(C.in[2] + idx); *(f32x4*)(C.out + O_SSSM + idx) = h0 * elast + acc[pt]; } }
        }
        if (uc < NCH && lane == 0) dec[uc * 32 + h] = elast;
        __syncthreads();
    }
}

__device__ __forceinline__ void phase_scan(const Ctx& C) {
    unsigned* st = (unsigned*)(C.ws + WS_ST); const float* dec = (const float*)(C.ws + WS_DEC);
    const int gt = C.bid * NT_ + C.tid, NGT = C.G * NT_;
    for (int e2 = gt; e2 < 32 * 8192 / 2; e2 += NGT) { const int h = e2 >> 12; float r0 = 0.f, r1 = 0.f;
        for (int c0 = 0; c0 < NCH; c0 += 8) { unsigned v[8]; float d[8];
#pragma unroll
            for (int i = 0; i < 8; ++i) { v[i] = st[(size_t)(c0 + i) * 131072 + e2]; d[i] = dec[(c0 + i) * 32 + h]; }
#pragma unroll
            for (int i = 0; i < 8; ++i) { st[(size_t)(c0 + i) * 131072 + e2] = pk2(r0, r1); r0 = r0 * d[i] + bflo(v[i]); r1 = r1 * d[i] + bfhi(v[i]); } }
        *(float2*)(C.out + O_PSSM + 2 * (size_t)e2) = make_float2(r0, r1); }
}

__device__ __forceinline__ void phase_ssd3(const Ctx& C) {
    const bf16_t* x2 = (const bf16_t*)(C.ws + WS_X2); const float* dt = (const float*)(C.ws + WS_DT); const bf16_t* st = (const bf16_t*)(C.ws + WS_ST);
    const bf16_t* zb = (const bf16_t*)(C.ws + WS_ZB); bf16_t* yb = (bf16_t*)(C.ws + WS_X1);
    LAS unsigned char* Cs = C.lds; LAS unsigned char* Bs = C.lds + 17408; LAS float* CB = (LAS float*)Bs;
    LAS unsigned char* Xs = C.lds + 34816 + C.wave * 9728; LAS float* ac = (LAS float*)(Xs + 9216); LAS float* ds = ac + 64;
    LAS float* red = (LAS float*)(C.lds + 34816 + 8 * 9728);
    const int lane = C.lane, gq = lane >> 4, li = lane & 15;
    for (int unit = C.bid; unit < SSD_UNITS; unit += C.G) {
        int uc, g, m0, L; ssd_unit_geom(unit, uc, g, m0, L);
        const int h = 8 * g + C.wave;
        ssd_load_tile128(C, Bs, x2, m0, L, DI + 128 * g);
        ssd_load_tile128(C, Cs, x2, m0, L, DI + 512 + 128 * g);
        const float Ah = -__expf(C.in[14][h]);
        const float dtv = (lane < L) ? dt[(size_t)(m0 + lane) * 32 + h] : 0.f;
        const float acum = wave_incl_scan(dtv * Ah, lane);
        ac[lane] = acum; ds[lane] = dtv;
#pragma unroll
        for (int i = 0; i < 8; ++i) { const int srow = 8 * i + (lane >> 3), pc = lane & 7; u32x4 v = {0u, 0u, 0u, 0u};
            if (srow < L) v = *(const u32x4*)(x2 + (size_t)(m0 + srow) * CONVD + 64 * h + 8 * pc);
            *(LAS u32x4*)(Xs + srow * RSX + 16 * pc) = v; }
        __syncthreads();
        f32x4 accb[2];
#pragma unroll
        for (int i = 0; i < 2; ++i) { const int id = 2 * C.wave + i, tt = id >> 2, sl = id & 3; accb[i] = (f32x4){0.f, 0.f, 0.f, 0.f};
#pragma unroll
            for (int kn = 0; kn < 4; ++kn) { const bf16x8 a = *(const LAS bf16x8*)(Cs + (16 * tt + li) * RSB + (32 * kn + 8 * gq) * 2), b = *(const LAS bf16x8*)(Bs + (16 * sl + li) * RSB + (32 * kn + 8 * gq) * 2);
                accb[i] = __builtin_amdgcn_mfma_f32_16x16x32_bf16(a, b, accb[i], 0, 0, 0); } }
        __syncthreads();
#pragma unroll
        for (int i = 0; i < 2; ++i) { const int id = 2 * C.wave + i, tt = id >> 2, sl = id & 3;
#pragma unroll
            for (int r = 0; r < 4; ++r) CB[(16 * tt + 4 * gq + r) * 68 + 16 * sl + li] = accb[i][r]; }
        __syncthreads();
        f32x4 acc[4][4];
#pragma unroll
        for (int tt = 0; tt < 4; ++tt)
#pragma unroll
            for (int pt = 0; pt < 4; ++pt) acc[tt][pt] = (f32x4){0.f, 0.f, 0.f, 0.f};
#pragma unroll
        for (int pt = 0; pt < 4; ++pt)
#pragma unroll
            for (int kn = 0; kn < 4; ++kn) { bf16x8 b;
                if (uc < NCH) b = *(const bf16x8*)(st + ((size_t)(uc * 32 + h) * 64 + 16 * pt + li) * 128 + 32 * kn + 8 * gq);
                else { const float* sp = C.in[2] + ((size_t)((uc - NCH) * 32 + h) * 64 + 16 * pt + li) * 128 + 32 * kn + 8 * gq; const f32x4 s0 = *(const f32x4*)sp, s1 = *(const f32x4*)(sp + 4);
                    const u32x4 w = {pk2(s0.x, s0.y), pk2(s0.z, s0.w), pk2(s1.x, s1.y), pk2(s1.z, s1.w)}; b = __builtin_bit_cast(bf16x8, w); }
#pragma unroll
                for (int tt = 0; tt < 4; ++tt) { const bf16x8 a = *(const LAS bf16x8*)(Cs + (16 * tt + li) * RSB + (32 * kn + 8 * gq) * 2); acc[tt][pt] = __builtin_amdgcn_mfma_f32_16x16x32_bf16(a, b, acc[tt][pt], 0, 0, 0); } }
#pragma unroll
        for (int tt = 0; tt < 4; ++tt)
#pragma unroll
            for (int r = 0; r < 4; ++r) { const float e = __expf(ac[16 * tt + 4 * gq + r]);
#pragma unroll
                for (int pt = 0; pt < 4; ++pt) acc[tt][pt][r] *= e; }
        bf16x8 xf[2][4];
#pragma unroll
        for (int ks = 0; ks < 2; ++ks)
#pragma unroll
            for (int pt = 0; pt < 4; ++pt) xf[ks][pt] = trfrag(Xs, RSX, 32 * ks, 16 * pt, lane);
#pragma unroll
        for (int tt = 0; tt < 4; ++tt) { const int t = 16 * tt + li; const float at = ac[t];
#pragma unroll
            for (int ks = 0; ks < 2; ++ks) { if (32 * ks > 16 * tt + 15) continue;
                const int s0 = 32 * ks + 8 * gq; float w[8];
                const f32x4 c0 = *(const LAS f32x4*)(CB + t * 68 + s0), c1 = *(const LAS f32x4*)(CB + t * 68 + s0 + 4);
                const f32x4 a0 = *(const LAS f32x4*)(ac + s0), a1 = *(const LAS f32x4*)(ac + s0 + 4), d0 = *(const LAS f32x4*)(ds + s0), d1 = *(const LAS f32x4*)(ds + s0 + 4);
#pragma unroll
                for (int j = 0; j < 4; ++j) { w[j] = (s0 + j <= t) ? c0[j] * __expf(at - a0[j]) * d0[j] : 0.f; w[4 + j] = (s0 + 4 + j <= t) ? c1[j] * __expf(at - a1[j]) * d1[j] : 0.f; }
                const u32x4 wp = pack8(w); const bf16x8 af = __builtin_bit_cast(bf16x8, wp);
#pragma unroll
                for (int pt = 0; pt < 4; ++pt) acc[tt][pt] = __builtin_amdgcn_mfma_f32_16x16x32_bf16(af, xf[ks][pt], acc[tt][pt], 0, 0, 0); } }
        const float Dh = C.in[15][h]; float sq[4][4];
#pragma unroll
        for (int tt = 0; tt < 4; ++tt)
#pragma unroll
            for (int r = 0; r < 4; ++r) { const int t = 16 * tt + 4 * gq + r; float s = 0.f;
#pragma unroll
                for (int pt = 0; pt < 4; ++pt) { const int p_ = 16 * pt + li; const float xv = bf1(*(const LAS bf16_t*)(Xs + t * RSX + 2 * p_));
                    const float z = (t < L) ? bf1(zb[(size_t)(m0 + t) * DI + 64 * h + p_]) : 0.f; const float v = (acc[tt][pt][r] + Dh * xv) * silu(z); acc[tt][pt][r] = v; s += v * v; }
                s += __shfl_xor(s, 1); s += __shfl_xor(s, 2); s += __shfl_xor(s, 4); s += __shfl_xor(s, 8); sq[tt][r] = s;
                if (li == 0) red[t * 8 + C.wave] = s; }
        __syncthreads();
        const float* nw = C.in[16];
#pragma unroll
        for (int tt = 0; tt < 4; ++tt)
#pragma unroll
            for (int r = 0; r < 4; ++r) { const int t = 16 * tt + 4 * gq + r; const f32x4 q0 = *(const LAS f32x4*)(red + t * 8), q1 = *(const LAS f32x4*)(red + t * 8 + 4);
                const float rs = rsqrtf((((q0.x + q0.y) + (q0.z + q0.w)) + ((q1.x + q1.y) + (q1.z + q1.w))) * (1.f / 512.f) + EPS);
                if (t < L) {
#pragma unroll
                    for (int pt = 0; pt < 4; ++pt) { const int ch = 64 * h + 16 * pt + li; yb[(size_t)(m0 + t) * DI + ch] = (bf16_t)f2bf(acc[tt][pt][r] * rs * nw[ch]); } } }
        __syncthreads();
    }
}

__device__ __forceinline__ void phase_cumsum(const Ctx& C) {
    float* cb = (float*)(C.ws + WS_CB); float* cs = (float*)(C.ws + WS_CS); LAS float* wt = (LAS float*)C.lds;
    for (int h = C.bid; h < NH; h += C.G) {
        const float* lf = C.out + O_PLF; float v[32]; float s = 0.f;
#pragma unroll
        for (int i = 0; i < 32; ++i) { v[i] = lf[(size_t)(32 * C.tid + i) * NH + h]; s += v[i]; }
        const float inc = wave_incl_scan(s, C.lane);
        if (C.lane == 63) wt[C.wave] = inc;
        __syncthreads();
        float base = inc - s;
#pragma unroll
        for (int w = 0; w < 8; ++w) if (w < C.wave) base += wt[w];
        float run = base;
#pragma unroll
        for (int i = 0; i < 32; ++i) { run += v[i]; cb[(size_t)h * MP + 32 * C.tid + i] = -run * LOG2E; }
        __syncthreads();
    }
    const int gw = C.bid * NW_ + C.wave, NGW = C.G * NW_;
    for (int idx = gw; idx < NSB * NH; idx += NGW) { const int b = idx >> 4, h = idx & 15; float v[17]; float s = 0.f;
#pragma unroll
        for (int i = 0; i < 17; ++i) { const int k = 17 * C.lane + i; float x = 0.f;
            if (k < PAST) x = C.in[7][((size_t)b * PAST + k) * NH + h]; else if (k < KL) x = C.out[O_SLF + ((size_t)b * SL + (k - PAST)) * NH + h];
            v[i] = x; s += x; }
        float run = wave_incl_scan(s, C.lane) - s;
#pragma unroll
        for (int i = 0; i < 17; ++i) { const int k = 17 * C.lane + i; run += v[i]; if (k < KL) cs[(size_t)idx * KL + k] = -run * LOG2E; } }
}

__device__ __forceinline__ void phase_attn_sample(const Ctx& C) {
    bf16_t* Qb = (bf16_t*)(C.ws + WS_QB); const float* cs = (const float*)(C.ws + WS_CS);
    LAS float* qs = (LAS float*)C.lds; LAS float* pbuf = (LAS float*)(C.lds + 4096) + C.wave * 1024; LAS float* comb = (LAS float*)(C.lds + 36864); LAS float* ml = (LAS float*)(C.lds + 69632);
    const int lane = C.lane;
    for (int unit = C.bid; unit < NSB * NH; unit += C.G) { const int b = unit >> 4, h = unit & 15;
        for (int i = C.tid; i < 1024; i += NT_) qs[i] = bf1(Qb[(size_t)(MP + 16 * b + (i >> 6)) * DM + 64 * h + (i & 63)]);
        __syncthreads();
        float m[16], l[16], o[16];
#pragma unroll
        for (int q = 0; q < 16; ++q) { m[q] = -1e30f; l[q] = 0.f; o[q] = 0.f; }
        for (int batch = C.wave; batch < 17; batch += 8) {
            const int key = batch * 64 + lane; const bool valid = key < KL; const int kc = valid ? key : KL - 1;
            const float* kp = (kc < PAST) ? C.in[5] + (((size_t)b * PAST + kc) * NH + h) * 64 : C.out + O_SK + (((size_t)b * SL + (kc - PAST)) * NH + h) * 64;
            float s[16];
#pragma unroll
            for (int q = 0; q < 16; ++q) s[q] = 0.f;
#pragma unroll 4
            for (int dc = 0; dc < 16; ++dc) { const f32x4 kv = ((const f32x4*)kp)[dc];
#pragma unroll
                for (int q = 0; q < 16; ++q) { const f32x4 qv = *(const LAS f32x4*)(qs + q * 64 + 4 * dc); s[q] += (kv.x * qv.x + kv.y * qv.y) + (kv.z * qv.z + kv.w * qv.w); } }
            const float bias = cs[(size_t)unit * KL + kc];
#pragma unroll
            for (int q = 0; q < 16; ++q) { const bool ok = valid && (kc < PAST || kc - PAST <= q); const float sv = ok ? s[q] + bias : -1e30f;
                const float mn = fmaxf(m[q], wave_max(sv)); const float p = ok ? exp2f(sv - mn) : 0.f; const float scl = exp2f(m[q] - mn);
                l[q] = l[q] * scl + wave_sum(p); o[q] *= scl; m[q] = mn; pbuf[lane * 16 + q] = p; }
            asm volatile("s_waitcnt lgkmcnt(0)" ::: "memory");
            for (int j = 0; j < 64; ++j) { const int kj = min(batch * 64 + j, KL - 1);
                const float* vp = (kj < PAST) ? C.in[6] + (((size_t)b * PAST + kj) * NH + h) * 64 : C.out + O_SV + (((size_t)b * SL + (kj - PAST)) * NH + h) * 64;
                const float vv = vp[lane];
#pragma unroll
                for (int q4 = 0; q4 < 4; ++q4) { const f32x4 p4 = *(const LAS f32x4*)(pbuf + j * 16 + 4 * q4); o[4 * q4] += p4.x * vv; o[4 * q4 + 1] += p4.y * vv; o[4 * q4 + 2] += p4.z * vv; o[4 * q4 + 3] += p4.w * vv; } }
        }
#pragma unroll
        for (int q = 0; q < 16; ++q) { comb[(C.wave * 16 + q) * 64 + lane] = o[q]; if (lane == 0) { ml[C.wave * 32 + q] = m[q]; ml[C.wave * 32 + 16 + q] = l[q]; } }
        __syncthreads();
        for (int i = C.tid; i < 1024; i += NT_) { const int q = i >> 6, d = i & 63; float mm = -1e30f;
#pragma unroll
            for (int w = 0; w < 8; ++w) mm = fmaxf(mm, ml[w * 32 + q]);
            float ll = 0.f, oo = 0.f;
#pragma unroll
            for (int w = 0; w < 8; ++w) { const float f = exp2f(ml[w * 32 + q] - mm); ll += ml[w * 32 + 16 + q] * f; oo += comb[(w * 16 + q) * 64 + d] * f; }
            Qb[(size_t)(MP + 16 * b + q) * DM + 64 * h + d] = (bf16_t)f2bf(oo / ll); }
        __syncthreads();
    }
}
__global__ void __launch_bounds__(NT_, 2) mega_fwd(Args a) {
    __builtin_assume(__builtin_amdgcn_workitem_id_y() == 0); __builtin_assume(__builtin_amdgcn_workitem_id_z() == 0);
    extern __shared__ __attribute__((aligned(16))) unsigned char lds[];
    cg::grid_group grid = cg::this_grid();
    Ctx C; C.lds = (LAS unsigned char*)lds; C.tid = threadIdx.x; C.lane = C.tid & 63; C.wave = __builtin_amdgcn_readfirstlane(C.tid >> 6); C.G = gridDim.x; C.bid = blockIdx.x;
    { const float* const* inp = (const float* const*)__builtin_amdgcn_kernarg_segment_ptr(); asm volatile("" : "+s"(inp)); C.in = inp; }     C.out = a.out; C.ws = a.ws;
    unsigned char* ws = a.ws;
    float* ssq = (float*)(ws + WS_SSQ); constexpr size_t SSQN = (size_t)M * 16;
    bf16_t* hb = (bf16_t*)(ws + WS_HB);
    const int lo = a.ph_lo, hi = a.ph_hi;
#define IN(k) (lo <= (k) && (k) < hi)
#define SEAM(k) do { if (IN(k) && IN((k) + 1)) grid.sync(); } while (0)
#define GEMM(EPI, E, Aop, Bop, N_, K_) do { pg8::Gemm g_{(const bf16_t*)(Aop), (const bf16_t*)(Bop), M, (N_), (K_)}; pg8::StaticOrder S_; S_.init(M, (N_), C.G, C.bid); \
        pg8::gemm_phase<EPI, pg8::StaticOrder, true, true>(C.lds, g_, S_, E); __syncthreads(); } while (0)
    if (IN(0)) phase_prologue(C);
    SEAM(0);
    if (IN(1)) { EpiIn E{ssq, (bf16_t*)(ws + WS_ZB), (bf16_t*)(ws + WS_X1), (float*)(ws + WS_DT)}; GEMM(EpiIn, E, hb, ws + WS_WIN, NIN_PAD, DM); }
    SEAM(1);
    if (IN(2)) phase_mconv(C);
    SEAM(2);
    if (IN(3)) phase_ssd1(C);
    SEAM(3);
    if (IN(4)) phase_scan(C);
    SEAM(4);
    if (IN(5)) phase_ssd3(C);
    SEAM(5);
    if (IN(6)) { EpiRes E{a.out, hb, ssq + SSQN}; GEMM(EpiRes, E, ws + WS_X1, ws + WS_WOUT, DM, DI); }
    SEAM(6);
    if (IN(7)) { EpiUp E{ssq + SSQN, (bf16_t*)(ws + WS_UP)}; GEMM(EpiUp, E, hb, ws + WS_WUP, NUP, DM); }
    SEAM(7);
    if (IN(8)) phase_fconv(C, 0);
    SEAM(8);
    if (IN(9)) { EpiRes E{a.out, hb, ssq + 2 * SSQN}; GEMM(EpiRes, E, ws + WS_G, ws + WS_WDN, DM, DFF); }
    SEAM(9);
    if (IN(10)) { EpiQkv E{ssq + 2 * SSQN, (bf16_t*)(ws + WS_QB), (bf16_t*)(ws + WS_KB), (bf16_t*)(ws + WS_VB), a.out, C.in[22]}; GEMM(EpiQkv, E, hb, ws + WS_WQ, NQ, DM); }
    SEAM(10);
    if (IN(11)) phase_cumsum(C);
    SEAM(11);
    if (IN(12)) {
        const attn_body::AttnTensors AT{(const attn_body::bf16*)(ws + WS_QB), (const attn_body::bf16*)(ws + WS_KB), (const attn_body::bf16*)(ws + WS_VB), (attn_body::bf16*)(ws + WS_QB)};
        const attn_body::StaticOrder S((int)C.G, (int)C.bid);
        attn_body::attn_phase<attn_body::StaticOrder>((char*)lds, AT, S, (const float*)(ws + WS_CB));
        __syncthreads();
        phase_attn_sample(C);
    }
    SEAM(12);
    if (IN(13)) { EpiRes E{a.out, hb, ssq + 3 * SSQN}; GEMM(EpiRes, E, ws + WS_QB, ws + WS_WO, DM, DM); }
    SEAM(13);
    if (IN(14)) { EpiUp E{ssq + 3 * SSQN, (bf16_t*)(ws + WS_UP)}; GEMM(EpiUp, E, hb, ws + WS_WUP + (size_t)NUP * DM * 2, NUP, DM); }
    SEAM(14);
    if (IN(15)) phase_fconv(C, 1);
    SEAM(15);
    if (IN(16)) { EpiRes E{a.out, hb, ssq}; GEMM(EpiRes, E, ws + WS_G, ws + WS_WDN + (size_t)DM * DFF * 2, DM, DFF); }
    SEAM(16);
    if (IN(17)) phase_final(C);
#undef IN
#undef SEAM
#undef GEMM
}
constexpr int N_PHASES = 18;
#ifndef MK_SPLIT
#define MK_SPLIT 0
#endif
extern "C" void kernel_launch(void* const* d_in, const int* in_sizes, int n_in, void* d_out, int out_size, void* d_ws, size_t ws_size, hipStream_t stream) {
    static int grid = 0;
    if (grid == 0) {
        if (n_in != 30 || (size_t)out_size != O_END || ws_size < WS_NEED) { fprintf(stderr, "kernel_launch: unexpected sizes n_in %d out %d (want %zu) ws %zu (need %zu)\n", n_in, out_size, (size_t)O_END, ws_size, (size_t)WS_NEED); grid = -1; return; }
        int dev = 0, cus = 0, per_cu = 0;
        hipGetDevice(&dev); hipDeviceGetAttribute(&cus, hipDeviceAttributeMultiprocessorCount, dev);
        hipFuncSetAttribute((const void*)mega_fwd, hipFuncAttributeMaxDynamicSharedMemorySize, LDS_TOTAL);
        hipOccupancyMaxActiveBlocksPerMultiprocessor(&per_cu, (const void*)mega_fwd, NT_, LDS_TOTAL);
        if (per_cu < 1) { fprintf(stderr, "kernel_launch: occupancy query says %d blocks per CU\n", per_cu); per_cu = 1; }
        (void)hipGetLastError();
        grid = cus * 1;
    }
    if (grid < 0) return;
    Args a{};
    for (int i = 0; i < 30; ++i) a.in[i] = (const float*)d_in[i];
    a.out = (float*)d_out; a.ws = (unsigned char*)d_ws;
#if MK_SPLIT
    for (int p = 0; p < N_PHASES; ++p) { a.ph_lo = p; a.ph_hi = p + 1; hipLaunchKernelGGL(mega_fwd, dim3(grid), dim3(NT_), LDS_TOTAL, stream, a); }
#else
    a.ph_lo = 0; a.ph_hi = N_PHASES;
    void* args[] = {&a};
    hipError_t e = hipLaunchCooperativeKernel((const void*)mega_fwd, dim3(grid), dim3(NT_), args, LDS_TOTAL, stream);
    if (e != hipSuccess) fprintf(stderr, "cooperative launch failed: %s (grid %d)\n", hipGetErrorString(e), grid);
#endif
}
```

```cpp
#include <hip/hip_runtime.h>
#include <hip/hip_cooperative_groups.h>
#include <cstdio>
#include <cstdint>
namespace cg = cooperative_groups;

namespace pg8 {
#define PG8_LAS __attribute__((address_space(3)))
typedef unsigned short bf16_t;
typedef short bf16x8 __attribute__((ext_vector_type(8)));
typedef float f32x4 __attribute__((ext_vector_type(4)));
typedef unsigned u32x4 __attribute__((ext_vector_type(4)));
constexpr int BM = 256, BK = 64, HALF = 128, HTB = HALF * BK * 2  , STAGE_BYTES = 8 * HTB, NXCD = 8, WGM = 8;

__host__ __device__ __forceinline__ int lds_byte(int r, int c) { const int st = (r >> 4) * 2 + (c >> 5), rr = r & 15, cc = c & 31, ob = rr * 64 + cc * 2; return st * 1024 + (ob ^ (((ob >> 9) & 1) << 5)); }
__host__ __device__ __forceinline__ void stage_rc(int b, int& R, int& C) { const int st = b / 1024, sb = b % 1024, swz = sb ^ (((sb >> 9) & 1) << 5); R = (st >> 1) * 16 + swz / 64; C = (st & 1) * 32 + (swz % 64) / 2; }
__host__ __device__ __forceinline__ int perm32(int rho) { const int n = rho >> 4, i = rho & 15; return 8 * (i >> 2) + 4 * n + (i & 3); }

struct Unit { int pm, pn; };
struct Gemm { const bf16_t* A; const bf16_t* Bt; int M, N, K; };

struct StaticOrder {
    int nM, nN, nwg, G, c;
    __host__ __device__ void init(int M, int N, int G_, int c_) { nM = M / BM; nN = N / BM; nwg = nM * nN; G = G_; c = c_; }
    __host__ __device__ bool next(int i, Unit& u) const {
        const long L = (long)i * G + c; if (L >= nwg) return false;
        int wgid = (int)L; { const int q = nwg / NXCD, r = nwg % NXCD, xcd = wgid % NXCD, off = wgid / NXCD; wgid = (xcd < r ? xcd * (q + 1) : r * (q + 1) + (xcd - r) * q) + off; }
        const int nig = WGM * nN, gid = wgid / nig, fm = gid * WGM, gsz = (nM - fm) < WGM ? (nM - fm) : WGM;
        u.pm = fm + ((wgid % nig) % gsz); u.pn = (wgid % nig) / gsz; return true;
    }
    __device__ __forceinline__ void a_ready(const Unit&) const {}
    __device__ __forceinline__ void done(const Unit&) const {}
};

__device__ __forceinline__ unsigned cvt_pk_bf16(float lo, float hi) { unsigned r; asm volatile("v_cvt_pk_bf16_f32 %0, %1, %2" : "=v"(r) : "v"(lo), "v"(hi)); return r; }
typedef float f32x2 __attribute__((ext_vector_type(2)));
__device__ __forceinline__ f32x2 gelu_pk(f32x2 v) {
    const f32x2 av = __builtin_elementwise_abs(v), d = av * 0.2316418882f + 1.0f;
    f32x2 t; t.x = __builtin_amdgcn_rcpf(d.x); t.y = __builtin_amdgcn_rcpf(d.y);
    f32x2 q = t * 0.5307027145f + (-0.7265760135f); q = q * t + 0.7107068705f; q = q * t + (-0.142248368f); q = q * t + 0.127414796f; q = q * t;
    const f32x2 s = (v * v) * (-0.72134752044f);
    f32x2 e; e.x = __builtin_amdgcn_exp2f(s.x); e.y = __builtin_amdgcn_exp2f(s.y);
    const f32x2 m = v * (q * e), r = v - m;
    f32x2 o; o.x = v.x < 0.f ? m.x : r.x; o.y = v.y < 0.f ? m.y : r.y; return o;
}

template <int ACT  > struct EpiBf16 {
    static constexpr bool PERM = true, AFTER_DRAIN = false; static_assert(ACT == 0 || ACT == 1, "EpiBf16: ACT is 0 (none) or 1 (gelu_pk)");
    bf16_t* O; int ldc; const float* bias; int split_cols; size_t split_stride; float scale0;
    __device__ __forceinline__ void operator()(const f32x4 (&acc)[2][2][4][2], const Unit& u, int wr, int wc, int fr, int fq) const {
        const int row0 = u.pm * BM + wr * 64 + fr; int colt = u.pn * BM; bf16_t* base = O;
        float sc = 1.f; if (split_cols) { const int t = colt / split_cols; base += (size_t)t * split_stride; colt -= t * split_cols; if (t == 0) sc = scale0; }
        const int col0 = colt + wc * 32 + 8 * fq, bcol0 = u.pn * BM + wc * 32 + 8 * fq;
        f32x4 bv[2][2];
#pragma unroll
        for (int bj = 0; bj < 2; ++bj)
#pragma unroll
            for (int n = 0; n < 2; ++n) bv[bj][n] = bias ? *(const f32x4*)(bias + bcol0 + bj * HALF + 4 * n) : (f32x4){0.f, 0.f, 0.f, 0.f};
#pragma unroll
        for (int ai = 0; ai < 2; ++ai)
#pragma unroll
            for (int m = 0; m < 4; ++m) { bf16_t* rowp = base + (size_t)(row0 + ai * HALF + m * 16) * ldc + col0;
#pragma unroll
                for (int bj = 0; bj < 2; ++bj) { f32x4 v0 = acc[ai][bj][m][0] + bv[bj][0], v1 = acc[ai][bj][m][1] + bv[bj][1];
                    if (ACT == 1) { f32x2 a = gelu_pk((f32x2){v0[0], v0[1]}), b = gelu_pk((f32x2){v0[2], v0[3]}), c = gelu_pk((f32x2){v1[0], v1[1]}), d = gelu_pk((f32x2){v1[2], v1[3]});
                        v0 = (f32x4){a.x, a.y, b.x, b.y}; v1 = (f32x4){c.x, c.y, d.x, d.y}; }
                    v0 = v0 * sc; v1 = v1 * sc; u32x4 w; w.x = cvt_pk_bf16(v0[0], v0[1]); w.y = cvt_pk_bf16(v0[2], v0[3]); w.z = cvt_pk_bf16(v1[0], v1[1]); w.w = cvt_pk_bf16(v1[2], v1[3]);
                    *(u32x4*)(rowp + bj * HALF) = w; } }
    }
};

struct PanelStats {
    unsigned* xbuf;
    unsigned* cnt;
    unsigned* tmo;
    int ntn; float eps;
    unsigned code;
    __device__ __forceinline__ bool run(const f32x4 (&v)[2][2][4][2], const Unit& u, int wr, int wc, int fr, int fq, PG8_LAS unsigned char* lds, int wid, int lane) const {
        typedef float f32x2v __attribute__((ext_vector_type(2)));
        PG8_LAS f32x2v* P = (PG8_LAS f32x2v*)lds;
        PG8_LAS f32x2v* S = (PG8_LAS f32x2v*)(lds + 8192);
        PG8_LAS unsigned* flag = (PG8_LAS unsigned*)(lds + 8192 + 2048);
#pragma unroll
        for (int ai = 0; ai < 2; ++ai)
#pragma unroll
            for (int m = 0; m < 4; ++m) {
                float s = 0.f;
#pragma unroll
                for (int bj = 0; bj < 2; ++bj)
#pragma unroll
                    for (int n = 0; n < 2; ++n) { const f32x4 x = v[ai][bj][m][n]; s += (x[0] + x[1]) + (x[2] + x[3]); }
                s += __shfl_xor(s, 16); s += __shfl_xor(s, 32);
                const float mw = s * (1.0f / 64.0f); float q = 0.f;
#pragma unroll
                for (int bj = 0; bj < 2; ++bj)
#pragma unroll
                    for (int n = 0; n < 2; ++n) { const f32x4 d = v[ai][bj][m][n] - mw; q += (d[0] * d[0] + d[1] * d[1]) + (d[2] * d[2] + d[3] * d[3]); }
                q += __shfl_xor(q, 16); q += __shfl_xor(q, 32);
                if (fq == 0) P[(ai * HALF + wr * 64 + m * 16 + fr) * 4 + wc] = (f32x2v){mw, q};
            }
        asm volatile("s_waitcnt lgkmcnt(0)" ::: "memory"); __builtin_amdgcn_s_barrier(); asm volatile("" ::: "memory");
#if defined(BROKEN_EXCHANGE_NO_WAIT)
#warning BROKEN CONTROL BUILD: the row-statistics exchange does not wait; results are wrong by design
        if (blockIdx.x >= 64) { const long long t0_ = clock64(); while (clock64() - t0_ < 60000) __builtin_amdgcn_s_sleep(8); }
#endif
        const int row = wid * 32 + (lane & 31);
        if (lane < 32) {
            const f32x2v a = P[row * 4 + 0], b = P[row * 4 + 1], c = P[row * 4 + 2], d = P[row * 4 + 3];
            const float mt = (a.x + b.x + c.x + d.x) * 0.25f;
            const float da = a.x - mt, db = b.x - mt, dc = c.x - mt, dd = d.x - mt;
            const float m2 = (a.y + b.y) + (c.y + d.y) + 64.0f * ((da * da + db * db) + (dc * dc + dd * dd));
            unsigned long long* slot = (unsigned long long*)xbuf + ((size_t)(u.pm * BM + row) * 4 + u.pn);
            __hip_atomic_store(slot, ((unsigned long long)__float_as_uint(m2) << 32) | __float_as_uint(mt), __ATOMIC_RELAXED, __HIP_MEMORY_SCOPE_AGENT);
        }
        asm volatile("s_waitcnt vmcnt(0)" ::: "memory");
        if (lane == 0) __hip_atomic_fetch_add(cnt + 64 * u.pm, 1u, __ATOMIC_RELAXED, __HIP_MEMORY_SCOPE_AGENT);
        if (wid == 0) {
            bool dead = false; const unsigned long long t0 = __builtin_amdgcn_s_memrealtime(); const unsigned want = 8u * (unsigned)ntn;
            for (;;) {
#if defined(BROKEN_EXCHANGE_NO_WAIT)
                break;
#endif
                if ((unsigned)__builtin_amdgcn_readfirstlane(__hip_atomic_load(cnt + 64 * u.pm, __ATOMIC_RELAXED, __HIP_MEMORY_SCOPE_AGENT)) >= want) break;
                if (__builtin_amdgcn_s_memrealtime() - t0 > 2000000ull) {
                    if (lane == 0) { unsigned expect = 0u; __hip_atomic_compare_exchange_strong(tmo + 1, &expect, code | (unsigned)(u.pm & 0xff), __ATOMIC_RELAXED, __ATOMIC_RELAXED, __HIP_MEMORY_SCOPE_AGENT);
                                     __hip_atomic_store(tmo, 1u, __ATOMIC_RELAXED, __HIP_MEMORY_SCOPE_AGENT); }
                    dead = true; break; }
                __builtin_amdgcn_s_sleep(2);
            }
            __builtin_amdgcn_fence(__ATOMIC_ACQUIRE, "agent");
            if (lane == 0) flag[0] = dead ? 1u : 0u;
        }
        asm volatile("s_waitcnt vmcnt(0) lgkmcnt(0)" ::: "memory"); __builtin_amdgcn_s_barrier(); asm volatile("" ::: "memory");
        const bool bad = flag[0] != 0u;
        if (lane < 32) {
            const unsigned long long* slot = (const unsigned long long*)xbuf + (size_t)(u.pm * BM + row) * 4; float mt[4], m2[4]; float ms = 0.f;
#pragma unroll
            for (int t = 0; t < 4; ++t) { if (t < ntn) { const unsigned long long w = __hip_atomic_load(slot + t, __ATOMIC_RELAXED, __HIP_MEMORY_SCOPE_AGENT); mt[t] = __uint_as_float((unsigned)w); m2[t] = __uint_as_float((unsigned)(w >> 32)); } else { mt[t] = 0.f; m2[t] = 0.f; } ms += mt[t]; }
            const float mean = ms / (float)ntn; float q = 0.f;
#pragma unroll
            for (int t = 0; t < 4; ++t) if (t < ntn) { const float dm = mt[t] - mean; q += m2[t] + 256.0f * dm * dm; }
            S[row] = (f32x2v){mean, 1.0f / sqrtf(q / (256.0f * (float)ntn) + eps)};
        }
        asm volatile("s_waitcnt lgkmcnt(0)" ::: "memory"); __builtin_amdgcn_s_barrier(); asm volatile("" ::: "memory");
        return bad;
    }
};
struct EpiLnRes {
    static constexpr bool PERM = false, AFTER_DRAIN = true;
    const float* base; float* out; int ldc; const float* bias; PanelStats st; unsigned poison;
    __device__ __forceinline__ void fused(f32x4 (&acc)[2][2][4][2], const Unit& u, int wr, int wc, int fr, int fq, PG8_LAS unsigned char* lds, int wid, int lane) const {
        typedef float f32x2v __attribute__((ext_vector_type(2)));
        const PG8_LAS f32x2v* S = (const PG8_LAS f32x2v*)(lds + 8192);
        const int col0 = u.pn * BM + wc * 32 + 4 * fq;
#pragma unroll
        for (int bj = 0; bj < 2; ++bj)
#pragma unroll
            for (int n = 0; n < 2; ++n) { const f32x4 bv = bias ? *(const f32x4*)(bias + col0 + bj * HALF + n * 16) : (f32x4){0.f, 0.f, 0.f, 0.f};
#pragma unroll
                for (int ai = 0; ai < 2; ++ai)
#pragma unroll
                    for (int m = 0; m < 4; ++m) acc[ai][bj][m][n] += bv; }
        f32x4 pre[4][2][2];
#pragma unroll
        for (int m = 0; m < 4; ++m) { const size_t off = (size_t)(u.pm * BM + wr * 64 + m * 16 + fr) * ldc + col0;
#pragma unroll
            for (int bj = 0; bj < 2; ++bj)
#pragma unroll
                for (int n = 0; n < 2; ++n) pre[m][bj][n] = *(const f32x4*)(base + off + bj * HALF + n * 16); }
        const bool bad = st.run(acc, u, wr, wc, fr, fq, lds, wid, lane) || poison != 0u;
        const float qnan = __builtin_nanf("");
#pragma unroll
        for (int ai = 0; ai < 2; ++ai)
#pragma unroll
            for (int m = 0; m < 4; ++m) { const int r = ai * HALF + wr * 64 + m * 16 + fr; const f32x2v sr = S[r]; const size_t off = (size_t)(u.pm * BM + r) * ldc + col0;
#pragma unroll
                for (int bj = 0; bj < 2; ++bj)
#pragma unroll
                    for (int n = 0; n < 2; ++n) { const f32x4 bs = ai == 0 ? pre[m][bj][n] : *(const f32x4*)(base + off + bj * HALF + n * 16); f32x4 o = bs + (acc[ai][bj][m][n] - sr.x) * sr.y;
                        if (bad) o = (f32x4){qnan, qnan, qnan, qnan}; *(f32x4*)(out + off + bj * HALF + n * 16) = o; }
                if (m & 1) asm volatile("" ::: "memory"); }
    }
};
struct EpiLnResLn {
    static constexpr bool PERM = false, AFTER_DRAIN = true;
    const float* base; float* out; bf16_t* xn; int ldc; const float* bias; PanelStats st1, st2; unsigned poison;
    __device__ __forceinline__ void fused(f32x4 (&acc)[2][2][4][2], const Unit& u, int wr, int wc, int fr, int fq, PG8_LAS unsigned char* lds, int wid, int lane) const {
        typedef float f32x2v __attribute__((ext_vector_type(2))); typedef unsigned u32x2v __attribute__((ext_vector_type(2)));
        const PG8_LAS f32x2v* S = (const PG8_LAS f32x2v*)(lds + 8192);
        const int col0 = u.pn * BM + wc * 32 + 4 * fq;
#pragma unroll
        for (int bj = 0; bj < 2; ++bj)
#pragma unroll
            for (int n = 0; n < 2; ++n) { const f32x4 bv = bias ? *(const f32x4*)(bias + col0 + bj * HALF + n * 16) : (f32x4){0.f, 0.f, 0.f, 0.f};
#pragma unroll
                for (int ai = 0; ai < 2; ++ai)
#pragma unroll
                    for (int m = 0; m < 4; ++m) acc[ai][bj][m][n] += bv; }
        bool bad = st1.run(acc, u, wr, wc, fr, fq, lds, wid, lane) || poison != 0u;
        const float qnan = __builtin_nanf("");
#pragma unroll
        for (int ai = 0; ai < 2; ++ai)
#pragma unroll
            for (int m = 0; m < 4; ++m) { const int r = ai * HALF + wr * 64 + m * 16 + fr; const f32x2v sr = S[r]; const size_t off = (size_t)(u.pm * BM + r) * ldc + col0;
#pragma unroll
                for (int bj = 0; bj < 2; ++bj)
#pragma unroll
                    for (int n = 0; n < 2; ++n) { const f32x4 bs = *(const f32x4*)(base + off + bj * HALF + n * 16); acc[ai][bj][m][n] = bs + (acc[ai][bj][m][n] - sr.x) * sr.y; }
                asm volatile("" : "+v"(acc[ai][0][m][0]), "+v"(acc[ai][0][m][1]), "+v"(acc[ai][1][m][0]), "+v"(acc[ai][1][m][1]));
                if (m & 1) asm volatile("" ::: "memory"); }
        const bool bad1 = bad;
        bad = st2.run(acc, u, wr, wc, fr, fq, lds, wid, lane) || bad;
#pragma unroll
        for (int ai = 0; ai < 2; ++ai)
#pragma unroll
            for (int m = 0; m < 4; ++m) { const int r = ai * HALF + wr * 64 + m * 16 + fr; const f32x2v sr = S[r]; const size_t off = (size_t)(u.pm * BM + r) * ldc + col0;
#pragma unroll
                for (int bj = 0; bj < 2; ++bj)
#pragma unroll
                    for (int n = 0; n < 2; ++n) { const f32x4 x1 = acc[ai][bj][m][n]; *(f32x4*)(out + off + bj * HALF + n * 16) = bad1 ? (f32x4){qnan, qnan, qnan, qnan} : x1;
                        const f32x4 o = (x1 - sr.x) * sr.y; u32x2v w; w.x = cvt_pk_bf16(o[0], o[1]); w.y = cvt_pk_bf16(o[2], o[3]);
                        if (bad) { w.x = 0x7fc07fc0u; w.y = 0x7fc07fc0u; } *(u32x2v*)(xn + off + bj * HALF + n * 16) = w; }
                asm volatile("" ::: "memory"); }
    }
};

template <class Epi, class Sched, bool ALIGN_EPI = false, bool SP2 = false>
__device__ __forceinline__ void gemm_phase(PG8_LAS unsigned char* lds, const Gemm g, const Sched& S, const Epi& E) {
    const int tid = threadIdx.x, wid = __builtin_amdgcn_readfirstlane(tid >> 6), lane = tid & 63, wr = wid >> 2, wc = wid & 3, fr = lane & 15, fq = lane >> 4;
    const int K = g.K, nt = K / BK;
    unsigned voffA[2], voffB[2];
#pragma unroll
    for (int i = 0; i < 2; ++i) { int R, C; stage_rc(tid * 16 + i * 8192, R, C); const int Rb = Epi::PERM ? ((R & ~31) + perm32(R & 31)) : R;
        voffA[i] = (unsigned)(R * K + C) * 2u; voffB[i] = (unsigned)(Rb * K + C) * 2u; }
    const size_t kstep = (size_t)(BK * 2);
    const size_t hstep = (size_t)HALF * K * 2;
    const size_t tstep = 2 * hstep;
    const unsigned ldsw = (unsigned)wid * 1024u;
    const int aoff = lds_byte(wr * 64 + fr, fq * 8), boff = lds_byte(wc * 32 + fr, fq * 8);
#define PG8_SA(b, h) (((b) * 2 + (h)) * HTB)
#define PG8_SB(b, h) ((4 + (b) * 2 + (h)) * HTB)
#define PG8_STAGE(bufoff, gbase, voff) do { _Pragma("unroll") for (int _i = 0; _i < 2; ++_i) \
        __builtin_amdgcn_global_load_lds((const unsigned*)((const char*)(gbase) + (voff)[_i]), (PG8_LAS unsigned*)(lds + (bufoff) + ldsw + _i * 8192), 16, 0, 0); } while (0)
#define PG8_LDA(dst, b, h) do { _Pragma("unroll") for (int m = 0; m < 4; ++m) _Pragma("unroll") for (int k = 0; k < 2; ++k) dst[m][k] = *(const PG8_LAS bf16x8*)(lds + PG8_SA(b, h) + aoff + m * 2048 + k * 1024); } while (0)
#define PG8_LDB(dst, b, h) do { _Pragma("unroll") for (int n = 0; n < 2; ++n) _Pragma("unroll") for (int k = 0; k < 2; ++k) dst[n][k] = *(const PG8_LAS bf16x8*)(lds + PG8_SB(b, h) + boff + n * 2048 + k * 1024); } while (0)
#define PG8_MMA(ai, bj, At, Bt) do { __builtin_amdgcn_s_setprio(1); _Pragma("unroll") for (int m = 0; m < 4; ++m) _Pragma("unroll") for (int n = 0; n < 2; ++n) _Pragma("unroll") for (int k = 0; k < 2; ++k) \
        acc[ai][bj][m][n] = __builtin_amdgcn_mfma_f32_16x16x32_bf16(Bt[n][k], At[m][k], acc[ai][bj][m][n], 0, 0, 0); __builtin_amdgcn_s_setprio(0); } while (0)
#define PG8_WAIT_V(n) asm volatile("s_waitcnt vmcnt(" #n ")" ::: "memory")
#define PG8_WAIT_L(n) asm volatile("s_waitcnt lgkmcnt(" #n ")" ::: "memory")
#define PG8_BAR __builtin_amdgcn_s_barrier()
#define PG8_SCHED __builtin_amdgcn_sched_barrier(0)
    Unit cur, nxt; int ui = 0;
    if (!S.next(0, cur)) return;
    f32x4 acc[2][2][4][2];
#pragma unroll
    for (int a = 0; a < 2; ++a)
#pragma unroll
        for (int b = 0; b < 2; ++b)
#pragma unroll
            for (int m = 0; m < 4; ++m)
#pragma unroll
                for (int n = 0; n < 2; ++n) acc[a][b][m][n] = (f32x4){0.f, 0.f, 0.f, 0.f};
    bf16x8 At[4][2], B0[2][2], B1[2][2];
    const char* cA = (const char*)g.A + (size_t)cur.pm * tstep; const char* cB = (const char*)g.Bt + (size_t)cur.pn * tstep;
    S.a_ready(cur);
    if constexpr (SP2) {
        PG8_STAGE(PG8_SB(0, 0), cB, voffB); PG8_STAGE(PG8_SB(0, 1), cB + hstep, voffB); PG8_STAGE(PG8_SA(0, 0), cA, voffA); PG8_STAGE(PG8_SA(0, 1), cA + hstep, voffA);
        if (wr == 1) PG8_BAR;
        PG8_WAIT_V(2); PG8_BAR;
        PG8_STAGE(PG8_SB(1, 0), cB + kstep, voffB); PG8_STAGE(PG8_SA(1, 0), cA + kstep, voffA); PG8_STAGE(PG8_SB(1, 1), cB + hstep + kstep, voffB);
        PG8_WAIT_V(6); PG8_BAR;
    } else {
        PG8_STAGE(PG8_SB(0, 0), cB, voffB); PG8_STAGE(PG8_SA(0, 0), cA, voffA); PG8_STAGE(PG8_SB(0, 1), cB + hstep, voffB); PG8_STAGE(PG8_SA(0, 1), cA + hstep, voffA);
        if (wr == 1) PG8_BAR;
        PG8_WAIT_V(4); PG8_BAR;
        PG8_STAGE(PG8_SB(1, 0), cB + kstep, voffB); PG8_STAGE(PG8_SA(1, 0), cA + kstep, voffA); PG8_STAGE(PG8_SB(1, 1), cB + hstep + kstep, voffB);
        PG8_WAIT_V(6); PG8_BAR;
    }
    for (;;) {
        const bool has_next = S.next(ui + 1, nxt);
        const char* nA = has_next ? (const char*)g.A + (size_t)nxt.pm * tstep : cA; const char* nB = has_next ? (const char*)g.Bt + (size_t)nxt.pn * tstep : cB;
        for (int t = 0; t < nt; t += 2) {
            const bool last = (t == nt - 2);
            const char* a1 = cA + (size_t)(t + 1) * kstep;
            const char* a2 = last ? nA : cA + (size_t)(t + 2) * kstep; const char* b2 = last ? nB : cB + (size_t)(t + 2) * kstep;
            const char* a3 = a2 + kstep; const char* b3 = b2 + kstep;
            if (last && has_next) S.a_ready(nxt);
            if constexpr (SP2) {
            PG8_LDB(B0, 0, 0); PG8_LDB(B1, 0, 1); PG8_SCHED; PG8_LDA(At, 0, 0); PG8_STAGE(PG8_SA(1, 1), a1 + hstep, voffA);
            PG8_WAIT_V(8); PG8_WAIT_L(0); PG8_BAR; PG8_MMA(0, 0, At, B0); PG8_MMA(0, 1, At, B1); PG8_BAR; PG8_SCHED;
            PG8_LDA(At, 0, 1); PG8_STAGE(PG8_SB(0, 0), b2, voffB); PG8_STAGE(PG8_SB(0, 1), b2 + hstep, voffB); PG8_STAGE(PG8_SA(0, 0), a2, voffA);
            PG8_WAIT_V(8); PG8_WAIT_L(0); PG8_BAR; PG8_MMA(1, 0, At, B0); PG8_MMA(1, 1, At, B1); PG8_BAR; PG8_SCHED;
            PG8_LDB(B0, 1, 0); PG8_LDB(B1, 1, 1); PG8_SCHED; PG8_LDA(At, 1, 0); PG8_STAGE(PG8_SA(0, 1), a2 + hstep, voffA);
            PG8_WAIT_V(8); PG8_WAIT_L(0); PG8_BAR; PG8_MMA(0, 0, At, B0); PG8_MMA(0, 1, At, B1); PG8_BAR; PG8_SCHED;
            PG8_LDA(At, 1, 1); PG8_STAGE(PG8_SB(1, 0), b3, voffB); PG8_STAGE(PG8_SB(1, 1), b3 + hstep, voffB); PG8_STAGE(PG8_SA(1, 0), a3, voffA);
            PG8_WAIT_V(8); PG8_WAIT_L(0); PG8_BAR; PG8_MMA(1, 0, At, B0); PG8_MMA(1, 1, At, B1); PG8_BAR; PG8_SCHED;
            } else {
            PG8_LDB(B0, 0, 0); PG8_SCHED; PG8_LDA(At, 0, 0); PG8_STAGE(PG8_SA(1, 1), a1 + hstep, voffA);
            PG8_WAIT_L(8); PG8_BAR; PG8_WAIT_L(0); PG8_MMA(0, 0, At, B0); PG8_BAR; PG8_SCHED;
            PG8_LDB(B1, 0, 1); PG8_STAGE(PG8_SB(0, 0), b2, voffB);
            PG8_BAR; PG8_WAIT_L(0); PG8_MMA(0, 1, At, B1); PG8_BAR;
            PG8_LDA(At, 0, 1); PG8_STAGE(PG8_SA(0, 0), a2, voffA);
            PG8_BAR; PG8_WAIT_L(0); PG8_MMA(1, 0, At, B0); PG8_BAR; PG8_SCHED;
            PG8_STAGE(PG8_SB(0, 1), b2 + hstep, voffB);
            PG8_WAIT_V(6); PG8_BAR; PG8_MMA(1, 1, At, B1); PG8_BAR;
            PG8_LDB(B0, 1, 0); PG8_SCHED; PG8_LDA(At, 1, 0); PG8_STAGE(PG8_SA(0, 1), a2 + hstep, voffA);
            PG8_WAIT_L(8); PG8_BAR; PG8_WAIT_L(0); PG8_MMA(0, 0, At, B0); PG8_BAR; PG8_SCHED;
            PG8_LDB(B1, 1, 1); PG8_STAGE(PG8_SB(1, 0), b3, voffB);
            PG8_BAR; PG8_WAIT_L(0); PG8_MMA(0, 1, At, B1); PG8_BAR;
            PG8_LDA(At, 1, 1); PG8_STAGE(PG8_SA(1, 0), a3, voffA);
            PG8_BAR; PG8_WAIT_L(0); PG8_MMA(1, 0, At, B0); PG8_BAR; PG8_SCHED;
            PG8_STAGE(PG8_SB(1, 1), b3 + hstep, voffB);
            PG8_WAIT_V(6); PG8_BAR; PG8_MMA(1, 1, At, B1); PG8_BAR;
            }
        }
        if constexpr (ALIGN_EPI) { if (wr == 0) PG8_BAR; }
        if constexpr (!Epi::AFTER_DRAIN) { E(acc, cur, wr, wc, fr, fq); S.done(cur); }
        if (!has_next) break;
#pragma unroll
        for (int a = 0; a < 2; ++a)
#pragma unroll
            for (int b = 0; b < 2; ++b)
#pragma unroll
                for (int m = 0; m < 4; ++m)
#pragma unroll
                    for (int n = 0; n < 2; ++n) acc[a][b][m][n] = (f32x4){0.f, 0.f, 0.f, 0.f};
        cur = nxt; cA = nA; cB = nB; ++ui;
        if constexpr (ALIGN_EPI) { if (wr == 1) PG8_BAR; }
    }
    PG8_WAIT_V(0);
    if constexpr (!ALIGN_EPI) { if (wr == 0) PG8_BAR; }
    PG8_BAR;
    if constexpr (Epi::AFTER_DRAIN) { E.fused(acc, cur, wr, wc, fr, fq, lds, wid, lane); S.done(cur); }
#undef PG8_SA
#undef PG8_SB
#undef PG8_STAGE
#undef PG8_LDA
#undef PG8_LDB
#undef PG8_MMA
#undef PG8_WAIT_V
#undef PG8_WAIT_L
#undef PG8_BAR
#undef PG8_SCHED
}
}
#include <hip/hip_bf16.h>
#include <cmath>
namespace attn_body {
using bf16=__hip_bfloat16;
using bf16x8=__attribute__((ext_vector_type(8)))short;
using s16x4=__attribute__((ext_vector_type(4)))short;
using f32x16=__attribute__((ext_vector_type(16)))float;
using u32x4=__attribute__((ext_vector_type(4)))unsigned;
using f32x4_t=__attribute__((ext_vector_type(4)))float;
__device__ __forceinline__ unsigned f2bf_(float f){unsigned u=__builtin_bit_cast(unsigned,f);return (u+0x7fffu+((u>>16)&1u))>>16;}
constexpr int BATCH=1,NHEAD=16,SEQ=16384,D=64,DM=NHEAD*D;
constexpr int NW=8,QBLK=32,QB=QBLK*NW,KVBLK=64,NQB=SEQ/QB;
constexpr int ATTN_PITCH=DM, ATTN_UNIT_ROWS=QB;
__device__ __forceinline__ int crow(int r,int hi){return (r&3)+8*(r>>2)+4*hi;}
#define SBAR() __builtin_amdgcn_sched_barrier(0)
__device__ __forceinline__ void cmask(f32x16&p0,f32x16&p1,int jb,int qrel,int hi){
  const float NEG=-INFINITY; int kb=64*jb+4*hi;
  #pragma unroll
  for(int r=0;r<16;++r){int kv=kb+(r&3)+8*(r>>2); if(kv>qrel)p0[r]=NEG; if(kv+32>qrel)p1[r]=NEG;}
}

constexpr int NSLOT=3, SLOTB=8192;
constexpr int LDS_K=0, LDS_V=NSLOT*SLOTB, LDS_WS=2*NSLOT*SLOTB, LDS_OST=LDS_WS+NW*64*4, LDS_CT=LDS_OST+NW*4096, LDS_BYTES=LDS_CT+SEQ*4;
constexpr float C2=0.125f*1.4426950408889634f;
__device__ __forceinline__ void glds16(const void*gsrc,unsigned lds_dst){unsigned keep;
  asm volatile("s_mov_b32 %0, m0\n\ts_mov_b32 m0, %2\n\ts_nop 0\n\tglobal_load_lds_dwordx4 %1, off\n\ts_mov_b32 m0, %0":"=&s"(keep):"v"(gsrc),"s"(lds_dst):"memory");}
__device__ __forceinline__ float max3f(float a,float b,float c){float r;asm("v_max3_f32 %0, %1, %2, %3":"=v"(r):"v"(a),"v"(b),"v"(c));return r;}
__device__ __forceinline__ float max2f(float a,float b){float r;asm("v_max_f32_e32 %0, %1, %2":"=v"(r):"v"(a),"v"(b));return r;}
__device__ __forceinline__ float fadd_s(float a,float b){float r;asm("v_add_f32_e32 %0, %1, %2":"=v"(r):"v"(a),"v"(b));return r;}
__device__ __forceinline__ float fsub_s(float a,float b){float r;asm("v_sub_f32_e32 %0, %1, %2":"=v"(r):"v"(a),"v"(b));return r;}
typedef float f32x2_t __attribute__((ext_vector_type(2))); typedef __bf16 bf16x2_t __attribute__((ext_vector_type(2)));
__device__ __forceinline__ unsigned cvtpk_s(float lo,float hi){f32x2_t v={lo,hi};bf16x2_t b=__builtin_convertvector(v,bf16x2_t);return __builtin_bit_cast(unsigned,b);}
#define WAIT_BAR(N) asm volatile("s_waitcnt vmcnt(" #N ") lgkmcnt(0)\n\ts_barrier":::"memory")

__device__ __forceinline__ void qkt(f32x16&p0,f32x16&p1,const char*Kslot,const bf16x8*qr,int r32,int hi,bf16x8 kbA,bf16x8 kbB,bf16x8 qx){
  const f32x16 z16=f32x16{};
  p0=__builtin_amdgcn_mfma_f32_32x32x16_bf16(kbA,qx,z16,0,0,0);p1=__builtin_amdgcn_mfma_f32_32x32x16_bf16(kbB,qx,z16,0,0,0);
  const char*kb=Kslot+hi*1024+r32*16;
  #pragma unroll
  for(int d0=0;d0<4;++d0){
    const bf16x8 b0=*reinterpret_cast<const bf16x8*>(kb+d0*2048);
    const bf16x8 b1=*reinterpret_cast<const bf16x8*>(kb+d0*2048+512);
    p0=__builtin_amdgcn_mfma_f32_32x32x16_bf16(b0,qr[d0],p0,0,0,0);p1=__builtin_amdgcn_mfma_f32_32x32x16_bf16(b1,qr[d0],p1,0,0,0);}
}
typedef __attribute__((address_space(3))) const char* lds_cptr;
typedef short v4i16_t __attribute__((ext_vector_type(4)));
__device__ __forceinline__ void kload8(bf16x8*kf,lds_cptr kp){
  kf[0]=*(const __attribute__((address_space(3))) bf16x8*)(kp);      kf[1]=*(const __attribute__((address_space(3))) bf16x8*)(kp+512);
  kf[2]=*(const __attribute__((address_space(3))) bf16x8*)(kp+2048); kf[3]=*(const __attribute__((address_space(3))) bf16x8*)(kp+2560);
  kf[4]=*(const __attribute__((address_space(3))) bf16x8*)(kp+4096); kf[5]=*(const __attribute__((address_space(3))) bf16x8*)(kp+4608);
  kf[6]=*(const __attribute__((address_space(3))) bf16x8*)(kp+6144); kf[7]=*(const __attribute__((address_space(3))) bf16x8*)(kp+6656);
}
__device__ __forceinline__ void kload2(bf16x8*kf,lds_cptr kp,int j){ kf[2*j]=*(const __attribute__((address_space(3))) bf16x8*)(kp+j*2048); kf[2*j+1]=*(const __attribute__((address_space(3))) bf16x8*)(kp+j*2048+512); }
__device__ __forceinline__ s16x4 vtr(lds_cptr p){ return __builtin_bit_cast(s16x4,__builtin_amdgcn_ds_read_tr16_b64_v4i16((__attribute__((address_space(3))) v4i16_t*)p)); }
__device__ __forceinline__ float rowmax(const f32x16&p0,const f32x16&p1){
  float a=max3f(p0[0],p0[1],p1[0]),b=max3f(p0[2],p0[3],p1[1]);a=max3f(a,p1[2],p1[3]);
  #pragma unroll
  for(int r=4;r<16;r+=4){a=max3f(a,p0[r],p0[r+1]);b=max3f(b,p0[r+2],p0[r+3]);a=max3f(a,p1[r],p1[r+1]);b=max3f(b,p1[r+2],p1[r+3]);}
  const float m=max2f(a,b);
  auto rr=__builtin_amdgcn_permlane32_swap(__float_as_uint(m),__float_as_uint(m),false,false);
  return max2f(__uint_as_float(rr[0]),__uint_as_float(rr[1]));
}
__device__ __forceinline__ void pv(f32x16*o,int vb,bf16x8 pa0,bf16x8 pa1,bf16x8 pa2,bf16x8 pa3){
  #pragma unroll
  for(int d0=0;d0<2;++d0){s16x4 lo[4],hi[4];
    #pragma unroll
    for(int ks=0;ks<4;++ks){
      asm volatile("ds_read_b64_tr_b16 %0,%1 offset:%c2":"=&v"(lo[ks]):"v"(vb),"i"(d0*4096+ks*1024):"memory");
      asm volatile("ds_read_b64_tr_b16 %0,%1 offset:%c2":"=&v"(hi[ks]):"v"(vb),"i"(d0*4096+ks*1024+512):"memory");}
    asm volatile("s_waitcnt lgkmcnt(0)":::"memory");SBAR();
    #define PK(k) (bf16x8){lo[k][0],lo[k][1],lo[k][2],lo[k][3],hi[k][0],hi[k][1],hi[k][2],hi[k][3]}
    o[d0]=__builtin_amdgcn_mfma_f32_32x32x16_bf16(pa0,PK(0),o[d0],0,0,0);
    o[d0]=__builtin_amdgcn_mfma_f32_32x32x16_bf16(pa1,PK(1),o[d0],0,0,0);
    o[d0]=__builtin_amdgcn_mfma_f32_32x32x16_bf16(pa2,PK(2),o[d0],0,0,0);
    o[d0]=__builtin_amdgcn_mfma_f32_32x32x16_bf16(pa3,PK(3),o[d0],0,0,0);
    #undef PK
  }
}

#ifndef ATTN_STORE16
#define ATTN_STORE16(p,v) (*(u32x4*)(p)=(v))
#endif
template<int THRL> __device__ __forceinline__ void attn_unit(int b,int h,int qb,const bf16*Q,const bf16*__restrict__ K,const bf16*__restrict__ V,bf16*O,char*shm,const float*__restrict__ cbh,int tskip){
  int tid_=threadIdx.x; asm volatile("":"+v"(tid_));
  const int tid=tid_,lane=tid&63,r32=lane&31,hi=lane>>5; const int wid=__builtin_amdgcn_readfirstlane(tid>>6);
  const long rowbase=(long)b*SEQ; const int q0=qb*QB;
  const bf16*Qw=Q+(rowbase+q0+wid*QBLK)*DM+h*D;
  const bf16*Kh=K+rowbase*DM+h*D,*Vh=V+rowbase*DM+h*D;
  const unsigned lds0=(unsigned)(uintptr_t)shm;
  float*wsf=(float*)(shm+LDS_WS)+wid*64;
  const bf16*ksrc=Kh+(long)lane*DM+wid*8;
  const bf16*vsrc=Vh+(long)(16*(wid&3)+(lane>>2))*DM+(wid>>2)*32+(lane&3)*8;
  const unsigned kdst=lds0+LDS_K+wid*1024, vdst=lds0+LDS_V+wid*1024;
  #define DMA_K(t,slot) glds16(ksrc+(long)(t)*KVBLK*DM,(unsigned)__builtin_amdgcn_readfirstlane(kdst+(slot)))
  #define DMA_V(t,slot) glds16(vsrc+(long)(t)*KVBLK*DM,(unsigned)__builtin_amdgcn_readfirstlane(vdst+(slot)))
  const int vb0=(int)(lds0+LDS_V)+((lane>>4)&1)*32+(lane&3)*8+(4*hi+((lane&15)>>2))*64;
  const char*Kbase=shm+LDS_K; bf16x8 kf[8];
  const lds_cptr shm3=(lds_cptr)shm; const lds_cptr kp0=shm3+LDS_K+hi*1024+r32*16; const lds_cptr vp0=shm3+LDS_V+((lane>>4)&1)*32+(lane&3)*8+(4*hi+((lane&15)>>2))*64;
  const int NT=(q0+QB)/KVBLK-tskip;
  { typedef __attribute__((address_space(3))) f32x4_t* l4p; const l4p ct4=(l4p)(shm3+LDS_CT); const f32x4_t* g4=(const f32x4_t*)cbh;
    (void)ct4; (void)g4; const float cref=cbh[q0+QB-1-tskip*KVBLK]; __attribute__((address_space(3))) unsigned* ctw=(__attribute__((address_space(3))) unsigned*)(shm3+LDS_CT);
    for(int i0=tid;i0<NT*64;i0+=NW*64*8){ float vv_[8];
      #pragma unroll
      for(int u_=0;u_<8;++u_){ const int i=i0+u_*NW*64; vv_[u_]=(i<NT*64)?cbh[i]:0.f; }
      #pragma unroll
      for(int u_=0;u_<8;++u_){ const int i=i0+u_*NW*64; if(i<NT*64){ const float v_=__builtin_fmaxf(vv_[u_]-cref,-240.f); const unsigned u1=f2bf_(v_); const float r1_=v_-__uint_as_float(u1<<16); const unsigned u2=f2bf_(r1_); ctw[i]=u1|(u2<<16); } } }
    asm volatile("s_waitcnt vmcnt(0) lgkmcnt(0)\n\ts_barrier":::"memory"); }
  const __attribute__((address_space(3))) unsigned* ctab=(const __attribute__((address_space(3))) unsigned*)(shm3+LDS_CT)+r32;
  #define MKQX(mv) ({ const float c_=(mv); const unsigned u1=f2bf_(c_); const float r1_=c_-__uint_as_float(u1<<16); const unsigned u2=f2bf_(r1_); const float r2_=r1_-__uint_as_float(u2<<16); const unsigned u3=f2bf_(r2_); u32x4 t_={0x3F803F80u,0x00003F80u|(u1<<16),u2|(u3<<16),0u}; if(hi){t_=(u32x4){0u,0u,0u,0u};} __builtin_bit_cast(bf16x8,t_); })
  bf16x8 qx=MKQX(0.f);
  #define KBIAS(cv) ({ u32x4 t_={(cv),0x3F800000u,0x3F803F80u,0u}; __builtin_bit_cast(bf16x8,t_); })
  DMA_K(0,0);DMA_V(0,0);DMA_K(1,SLOTB);
  bf16x8 qr[4];
  #pragma unroll
  for(int d0=0;d0<4;++d0)qr[d0]=*reinterpret_cast<const bf16x8*>(&Qw[(long)r32*DM+d0*16+hi*8]);
  float mhat=0.f,l_reg=0.f;f32x16 o[2];o[0]=f32x16{};o[1]=f32x16{};
  const int qrel=wid*QBLK+r32;
  #define CMASK(P0,P1,t) do{int jb_=(t)-(NT-4); if(jb_>=0)cmask(P0,P1,jb_,qrel,hi);}while(0)
  bool resc=false;
  #define START(P0,P1) do{ const float rm=rowmax(P0,P1); resc=false; \
    { const float dl=rm; mhat=fadd_s(mhat,dl); \
      _Pragma("unroll") for(int r=0;r<16;++r){P0[r]=fsub_s(P0[r],dl);P1[r]=fsub_s(P1[r],dl);} \
      qx=MKQX(-mhat); } \
    _Pragma("unroll") for(int r=0;r<16;++r)P0[r]=__builtin_amdgcn_exp2f(P0[r]); }while(0)
  #define RESC() do{ if(resc){ asm volatile("s_waitcnt lgkmcnt(0)":::"memory"); \
      _Pragma("unroll") for(int d_=0;d_<2;++d_) _Pragma("unroll") for(int r=0;r<16;++r)o[d_][r]*=wsf[crow(r,hi)]; } }while(0)
  f32x16 pA0,pA1,pB0,pB1;
  int sl_prev=0,sl_cur=0,sl_next=SLOTB;
  #define ROT() do{sl_prev=sl_cur;sl_cur=sl_next;sl_next=(sl_next==(NSLOT-1)*SLOTB)?0:sl_next+SLOTB;}while(0)
  DMA_K(2,2*SLOTB);
  WAIT_BAR(3);
  qkt(pA0,pA1,Kbase,qr,r32,hi,KBIAS(ctab[0]),KBIAS(ctab[32]),qx);asm volatile("s_nop 15\n\ts_nop 7":"+v"(pA0),"+v"(pA1));CMASK(pA0,pA1,0);
  START(pA0,pA1);
  _Pragma("unroll") for(int r=0;r<16;++r)pA1[r]=__builtin_amdgcn_exp2f(pA1[r]);
  WAIT_BAR(0);
  DMA_K(3,0);DMA_V(1,SLOTB);
  ROT();
  kload8(kf,kp0+sl_cur);
  WAIT_BAR(2);
  s16x4 vlo[8],vhi[8]; u32x4 pw0,pw1,pw2,pw3;
  #define PKW(P,B) cvtpk_s(P[B],P[B+1])
  #define PAF(k) __builtin_bit_cast(bf16x8,pw##k)
  #define VFR(i) (bf16x8){vlo[i][0],vlo[i][1],vlo[i][2],vlo[i][3],vhi[i][0],vhi[i][1],vhi[i][2],vhi[i][3]}
  #define PIN(x) asm volatile("":"+v"(x))
  #define MX3(a,b,c) __builtin_fmaxf(__builtin_fmaxf((a),(b)),(c))
  #define GAPA(MF,A0,A1,A2,A3,W0,W1,PW) do{ MF; sacc+=A0; sacc+=A1; sacc+=A2; sacc+=A3; PIN(sacc); W0; W1; PIN(PW); SBAR(); }while(0)
  #define EX(v) __builtin_amdgcn_exp2f(v)
  #define GAPB(MF,X,B) do{ MF; X[B]=EX(X[B]); X[B+1]=EX(X[B+1]); X[B+2]=EX(X[B+2]); X[B+3]=EX(X[B+3]); PIN(X); SBAR(); }while(0)
  #define VRD(i) do{ vlo[i]=vtr(vp_+(((i)>>2)*4096+((i)&3)*1024)); vhi[i]=vtr(vp_+(((i)>>2)*4096+((i)&3)*1024+512)); }while(0)
  #define KRD(G,j) do{ if(G){ kload2(kf,kp0+sl_next,j); SBAR(); } }while(0)
  #define STEP(C0,C1,P0,P1,t,GK,GV,GL) do{ SBAR(); \
    const lds_cptr vp_=vp0+sl_prev; \
    const f32x16 z16_=f32x16{}; \
    VRD(0); SBAR(); float sacc=(P0[0]+P0[1]); \
    GAPA(C0=__builtin_amdgcn_mfma_f32_32x32x16_bf16(kf[0],qr[0],z16_,0,0,0), P0[2],P0[3],P0[4],P0[5],     pw0[0]=PKW(P0,0), pw0[1]=PKW(P0,2), pw0); \
    VRD(4); SBAR(); GAPA(C1=__builtin_amdgcn_mfma_f32_32x32x16_bf16(kf[1],qr[0],z16_,0,0,0), P0[6],P0[7],P0[8],P0[9],     pw0[2]=PKW(P0,4), pw0[3]=PKW(P0,6), pw0); \
    VRD(1); SBAR(); GAPA(C0=__builtin_amdgcn_mfma_f32_32x32x16_bf16(kf[2],qr[1],C0,0,0,0),   P0[10],P0[11],P0[12],P0[13], pw1[0]=PKW(P0,8), pw1[1]=PKW(P0,10), pw1); \
    VRD(5); SBAR(); GAPA(C1=__builtin_amdgcn_mfma_f32_32x32x16_bf16(kf[3],qr[1],C1,0,0,0),   P0[14],P0[15],P1[0],P1[1],   pw1[2]=PKW(P0,12),pw1[3]=PKW(P0,14), pw1); \
    VRD(2); SBAR(); GAPA(C0=__builtin_amdgcn_mfma_f32_32x32x16_bf16(kf[4],qr[2],C0,0,0,0),   P1[2],P1[3],P1[4],P1[5],     pw2[0]=PKW(P1,0), pw2[1]=PKW(P1,2), pw2); \
    VRD(6); SBAR(); GAPA(C1=__builtin_amdgcn_mfma_f32_32x32x16_bf16(kf[5],qr[2],C1,0,0,0),   P1[6],P1[7],P1[8],P1[9],     pw2[2]=PKW(P1,4), pw2[3]=PKW(P1,6), pw2); \
    VRD(3); SBAR(); GAPA(C0=__builtin_amdgcn_mfma_f32_32x32x16_bf16(kf[6],qr[3],C0,0,0,0),   P1[10],P1[11],P1[12],P1[13], pw3[0]=PKW(P1,8), pw3[1]=PKW(P1,10), pw3); \
    VRD(7); SBAR(); GAPA(C1=__builtin_amdgcn_mfma_f32_32x32x16_bf16(kf[7],qr[3],C1,0,0,0),   P1[14],P1[15],0.f,0.f,       pw3[2]=PKW(P1,12),pw3[3]=PKW(P1,14), pw3); \
    { const bf16x8 kbA_=KBIAS(ctab[(t)*64]), kbB_=KBIAS(ctab[(t)*64+32]); C0=__builtin_amdgcn_mfma_f32_32x32x16_bf16(kbA_,qx,C0,0,0,0); C1=__builtin_amdgcn_mfma_f32_32x32x16_bf16(kbB_,qx,C1,0,0,0); } SBAR(); \
    l_reg+=sacc; \
    if(GK){DMA_K((t)+3,sl_cur);} if(GV){DMA_V((t)+1,sl_next);} \
    CMASK(C0,C1,t); \
    { float a=MX3(C0[0],C0[1],C1[0]),b=MX3(C0[2],C0[3],C1[1]); a=MX3(a,C1[2],C1[3]); \
      _Pragma("unroll") for(int r=4;r<16;r+=4){a=MX3(a,C0[r],C0[r+1]);b=MX3(b,C0[r+2],C0[r+3]);a=MX3(a,C1[r],C1[r+1]);b=MX3(b,C1[r+2],C1[r+3]);} \
      float rm=__builtin_fmaxf(a,b); { auto rr=__builtin_amdgcn_permlane32_swap(__float_as_uint(rm),__float_as_uint(rm),false,false); rm=__builtin_fmaxf(__uint_as_float(rr[0]),__uint_as_float(rr[1])); } \
      resc=false; \
      if(__builtin_expect(__any(rm>(float)THRL),0)){ const float dl=__builtin_fmaxf(rm,0.f); mhat+=dl; \
        _Pragma("unroll") for(int r=0;r<16;++r){C0[r]-=dl;C1[r]-=dl;} \
        qx=MKQX(-mhat); \
        const float f=__builtin_amdgcn_exp2f(-dl); l_reg*=f; if(hi==0)wsf[r32]=f; resc=true; } } \
    SBAR(); \
    GAPB(o[0]=__builtin_amdgcn_mfma_f32_32x32x16_bf16(PAF(0),VFR(0),o[0],0,0,0), C0,0); \
    GAPB(o[1]=__builtin_amdgcn_mfma_f32_32x32x16_bf16(PAF(0),VFR(4),o[1],0,0,0), C0,4); \
    KRD(GL,0); GAPB(o[0]=__builtin_amdgcn_mfma_f32_32x32x16_bf16(PAF(1),VFR(1),o[0],0,0,0), C0,8); \
    KRD(GL,1); GAPB(o[1]=__builtin_amdgcn_mfma_f32_32x32x16_bf16(PAF(1),VFR(5),o[1],0,0,0), C0,12); \
    KRD(GL,2); GAPB(o[0]=__builtin_amdgcn_mfma_f32_32x32x16_bf16(PAF(2),VFR(2),o[0],0,0,0), C1,0); \
    KRD(GL,3); GAPB(o[1]=__builtin_amdgcn_mfma_f32_32x32x16_bf16(PAF(2),VFR(6),o[1],0,0,0), C1,4); \
    GAPB(o[0]=__builtin_amdgcn_mfma_f32_32x32x16_bf16(PAF(3),VFR(3),o[0],0,0,0), C1,8); \
    GAPB(o[1]=__builtin_amdgcn_mfma_f32_32x32x16_bf16(PAF(3),VFR(7),o[1],0,0,0), C1,12); \
    }while(0)
  int t=1;
  #undef CMASK
  #define CMASK(P0,P1,t) do{}while(0)
  for(;t+5<NT;t+=2){
    STEP(pB0,pB1,pA0,pA1,t,true,true,true);     WAIT_BAR(2); RESC(); ROT();
    STEP(pA0,pA1,pB0,pB1,t+1,true,true,true);   WAIT_BAR(2); RESC(); ROT();
  }
  #undef CMASK
  #define CMASK(P0,P1,t) do{int jb_=(t)-(NT-4); if(jb_>=0)cmask(P0,P1,jb_,qrel,hi);}while(0)
  #define ENDW(tt) do{ if((tt)+3<NT){WAIT_BAR(2);} else if((tt)+2<NT){WAIT_BAR(1);} else {WAIT_BAR(0);} }while(0)
  for(;t+1<NT;t+=2){
    STEP(pB0,pB1,pA0,pA1,t,(t+3<NT),(t+1<NT),(t+1<NT));       ENDW(t);   RESC(); ROT();
    STEP(pA0,pA1,pB0,pB1,t+1,(t+4<NT),(t+2<NT),(t+2<NT));     ENDW(t+1); RESC(); ROT();
  }
  STEP(pB0,pB1,pA0,pA1,NT-1,false,false,false); RESC();
  { float sacc=pB0[0]+pB0[1]; _Pragma("unroll") for(int r=2;r<16;++r)sacc+=pB0[r]; _Pragma("unroll") for(int r=0;r<16;++r)sacc+=pB1[r]; l_reg+=sacc;
    pw0=(u32x4){PKW(pB0,0),PKW(pB0,2),PKW(pB0,4),PKW(pB0,6)};pw1=(u32x4){PKW(pB0,8),PKW(pB0,10),PKW(pB0,12),PKW(pB0,14)};pw2=(u32x4){PKW(pB1,0),PKW(pB1,2),PKW(pB1,4),PKW(pB1,6)};pw3=(u32x4){PKW(pB1,8),PKW(pB1,10),PKW(pB1,12),PKW(pB1,14)};
    SBAR(); pv(o,vb0+sl_cur,PAF(0),PAF(1),PAF(2),PAF(3)); }
  #undef PKW
  #undef PAF
  #undef VFR
  #undef PIN
  #undef MX3
  #undef GAPA
  #undef GAPB
  #undef EX
  #undef VRD
  #undef KRD
  #undef STEP
  #undef ENDW
  {auto rr=__builtin_amdgcn_permlane32_swap(__float_as_uint(l_reg),__float_as_uint(l_reg),false,false);l_reg=__uint_as_float(rr[0])+__uint_as_float(rr[1]);}
  if(hi==0)wsf[32+r32]=l_reg;asm volatile("s_waitcnt lgkmcnt(0)":::"memory");
  float rli[16];
  #pragma unroll
  for(int r=0;r<16;++r)rli[r]=__builtin_amdgcn_rcpf(wsf[32+crow(r,hi)]);
  bf16*Ow=O+(rowbase+q0+wid*QBLK)*DM+h*D;
  { bf16*stg=(bf16*)(shm+LDS_OST)+wid*2048;
    #pragma unroll
    for(int r=0;r<16;++r){const int orow=crow(r,hi);
      #pragma unroll
      for(int d0=0;d0<2;++d0)stg[orow*64+d0*32+r32]=__float2bfloat16(o[d0][r]*rli[r]);}
    asm volatile("s_waitcnt lgkmcnt(0)":::"memory");
    #pragma unroll
    for(int i=0;i<4;++i){const int row=i*8+(lane>>3),ch=lane&7; const u32x4 v=*(const u32x4*)(stg+row*64+ch*8); ATTN_STORE16(Ow+(long)row*DM+ch*8,v);} }
  asm volatile("s_waitcnt lgkmcnt(0)\n\ts_barrier":::"memory");
  #undef KBIAS
  #undef MKQX
  #undef DMA_K
  #undef DMA_V
  #undef CMASK
  #undef START
  #undef RESC
  #undef ROT
}
constexpr int ATTN_LDS_BYTES=LDS_BYTES;
struct AttnTensors { const bf16* Q; const bf16* K; const bf16* V; bf16* O; };
struct AttnUnit { int bh; int qb; };
struct StaticOrder {
  int G,c;
  __device__ __forceinline__ StaticOrder(int grid,int block):G(grid),c(block){}
  __device__ __forceinline__ bool next(int i,AttnUnit&u)const{ const int j=i*G+((i&1)?(G-1-c):c); if(j>=NHEAD*NQB)return false; u.bh=j%NHEAD; u.qb=NQB-1-j/NHEAD; return true; }
  __device__ __forceinline__ void a_ready(const AttnUnit&)const{}
  __device__ __forceinline__ void done(const AttnUnit&)const{}
};
constexpr float SKIP_T=40.f;
template<class Sched,int THRL=8> __device__ __forceinline__ void attn_phase(char*lds,const AttnTensors&T,const Sched&S,const float*cb,const float*nrm){
  AttnUnit u; const int tid=threadIdx.x;
  __attribute__((address_space(3))) int* redi=(__attribute__((address_space(3))) int*)((lds_cptr)lds+LDS_CT);
  for(int i=0;S.next(i,u);++i){ S.a_ready(u);
    const int h=u.bh%NHEAD, q0=u.qb*QB, NT0=(q0+QB)/KVBLK; const float* cbh=cb+(long)h*SEQ; const float* qn=nrm+h*(SEQ/KVBLK)+4*u.qb; const float* kn=nrm+NHEAD*(SEQ/KVBLK)+h*(SEQ/KVBLK);
    int tt=tid; asm volatile("":"+v"(tt));
    const float qmx=__builtin_fmaxf(__builtin_fmaxf(qn[0],qn[1]),__builtin_fmaxf(qn[2],qn[3]));
    const float kdg=__builtin_fmaxf(__builtin_fmaxf(kn[4*u.qb],kn[4*u.qb+1]),__builtin_fmaxf(kn[4*u.qb+2],kn[4*u.qb+3]));
    if(tid==0) redi[0]=NT0;
    asm volatile("s_waitcnt vmcnt(0) lgkmcnt(0)\n\ts_barrier":::"memory");
    if(tt<NT0){ const bool skip_=(cbh[(unsigned)(tt*KVBLK+KVBLK-1)]-cbh[q0]+qmx*(kn[(unsigned)tt]+kdg))<-SKIP_T; if(!skip_) __hip_atomic_fetch_min(redi,tt,__ATOMIC_RELAXED,__HIP_MEMORY_SCOPE_WORKGROUP); }
    asm volatile("s_waitcnt vmcnt(0) lgkmcnt(0)\n\ts_barrier":::"memory");
    int tskip=redi[0]; tskip=tskip<NT0-8?tskip:NT0-8; tskip=tskip>0?(tskip&~1):0; tskip=__builtin_amdgcn_readfirstlane(tskip);
    asm volatile("s_waitcnt lgkmcnt(0)\n\ts_barrier":::"memory");
    attn_unit<THRL>(u.bh/NHEAD,h,u.qb,T.Q,T.K+(long)tskip*KVBLK*DM,T.V+(long)tskip*KVBLK*DM,T.O,lds,cbh+tskip*KVBLK,tskip); S.done(u); }
}
#undef SBAR
#undef WAIT_BAR
}
#define LAS __attribute__((address_space(3)))
typedef unsigned short bf16_t;
typedef short bf16x8 __attribute__((ext_vector_type(8)));
typedef short s16x4 __attribute__((ext_vector_type(4)));
typedef float f32x4 __attribute__((ext_vector_type(4)));
typedef unsigned u32x4 __attribute__((ext_vector_type(4)));
typedef unsigned u32x2 __attribute__((ext_vector_type(2)));

constexpr int MP = 16384, MS = 512, M = MP + MS, DM = 1024;
constexpr int DI = 2048, CONVD = 3072, NIN = 5152, NIN_PAD = 5376, NHM = 32;
constexpr int DFF = 2816, NUP = 5632, NQ = 3328, NH = 16;
constexpr int NSB = 32, SL = 16, PAST = 1024, KL = PAST + SL;
constexpr float EPS = 1e-6f, LOG2E = 1.4426950408889634f, C2Q = 0.125f * 1.4426950408889634f;
constexpr int NCH = MP / 64;
constexpr size_t O_Y = 0, O_PSSM = (size_t)M * DM, O_PMC = O_PSSM + 32 * 64 * 128, O_PFC = O_PMC + 3 * CONVD, O_PK = O_PFC + 2 * 2 * NUP,
                 O_PV = O_PK + (size_t)MP * DM, O_PLF = O_PV + (size_t)MP * DM, O_SSSM = O_PLF + (size_t)MP * NH, O_SMC = O_SSSM + (size_t)NSB * 32 * 64 * 128,
                 O_SFC = O_SMC + (size_t)NSB * 3 * CONVD, O_SK = O_SFC + (size_t)2 * NSB * 2 * NUP, O_SV = O_SK + (size_t)MS * DM, O_SLF = O_SV + (size_t)MS * DM,
                 O_END = O_SLF + (size_t)MS * NH;
constexpr size_t al(size_t x) { return (x + 255) & ~(size_t)255; }
constexpr size_t WS_BAR = 0;
constexpr size_t WS_NRM = 16384;
constexpr size_t WS_SSQ = 16384 + 65536;
constexpr size_t WS_DT = WS_SSQ + al((size_t)4 * M * 16 * 4);
constexpr size_t WS_DEC = WS_DT + al((size_t)M * 32 * 4);
constexpr size_t WS_CB = WS_DEC + al((size_t)NCH * 32 * 4);
constexpr size_t WS_CS = WS_CB + al((size_t)NH * MP * 4);
constexpr size_t WS_WIN = WS_CS + al((size_t)NSB * NH * KL * 4);
constexpr size_t WS_WOUT = WS_WIN + al((size_t)NIN_PAD * DM * 2);
constexpr size_t WS_WUP = WS_WOUT + al((size_t)DM * DI * 2);
constexpr size_t WS_WDN = WS_WUP + al((size_t)2 * NUP * DM * 2);
constexpr size_t WS_WQ = WS_WDN + al((size_t)2 * DM * DFF * 2);
constexpr size_t WS_WO = WS_WQ + al((size_t)NQ * DM * 2);
constexpr size_t WS_HB = WS_WO + al((size_t)DM * DM * 2);
constexpr size_t WS_S0 = WS_HB + al((size_t)M * DM * 2);
constexpr size_t WS_ZB = WS_S0;
constexpr size_t WS_X1 = WS_ZB + al((size_t)M * DI * 2);
constexpr size_t WS_X2 = WS_X1 + al((size_t)M * CONVD * 2);
constexpr size_t WS_ST = WS_X2 + al((size_t)M * CONVD * 2);
constexpr size_t WS_END1 = WS_ST + al((size_t)NCH * 32 * 8192 * 2);
constexpr size_t WS_UP = WS_S0;
constexpr size_t WS_EDGE = WS_UP;
constexpr size_t WS_UPS = WS_EDGE + al((size_t)(M / 64) * 4 * NUP * 4);
constexpr size_t WS_G = WS_UP + al((size_t)M * NUP * 2);
constexpr size_t WS_QB = WS_G + al((size_t)M * DFF * 2);
constexpr size_t WS_KB = WS_QB + al((size_t)M * DM * 2);
constexpr size_t WS_VB = WS_KB + al((size_t)M * DM * 2);
constexpr size_t WS_END2 = WS_VB + al((size_t)M * DM * 2);
constexpr size_t WS_NEED = WS_END1 > WS_END2 ? WS_END1 : WS_END2;

constexpr int NT_ = 512, NW_ = 8;
constexpr int LDS_TOTAL = 151552;

struct Args { const float* in[30]; float* out; unsigned char* ws; int ph_lo, ph_hi; };

__device__ __forceinline__ unsigned f2bf(float f) { unsigned u = __builtin_bit_cast(unsigned, f); return (u + 0x7fffu + ((u >> 16) & 1u)) >> 16; }
__device__ __forceinline__ unsigned pk2(float lo, float hi) { typedef float f2 __attribute__((ext_vector_type(2))); typedef __bf16 b2 __attribute__((ext_vector_type(2))); f2 v = {lo, hi}; b2 b = __builtin_convertvector(v, b2); return __builtin_bit_cast(unsigned, b); }
__device__ __forceinline__ float bflo(unsigned u) { return __uint_as_float(u << 16); }
__device__ __forceinline__ float bfhi(unsigned u) { return __uint_as_float(u & 0xffff0000u); }
__device__ __forceinline__ float bf1(bf16_t u) { return __uint_as_float((unsigned)u << 16); }
__device__ __forceinline__ void unpack8(u32x4 v, float* f) { f[0] = bflo(v.x); f[1] = bfhi(v.x); f[2] = bflo(v.y); f[3] = bfhi(v.y); f[4] = bflo(v.z); f[5] = bfhi(v.z); f[6] = bflo(v.w); f[7] = bfhi(v.w); }
__device__ __forceinline__ u32x4 pack8(const float* f) { u32x4 o; o.x = pk2(f[0], f[1]); o.y = pk2(f[2], f[3]); o.z = pk2(f[4], f[5]); o.w = pk2(f[6], f[7]); return o; }
__device__ __forceinline__ float wave_sum(float v) {
#pragma unroll
    for (int o = 1; o < 64; o <<= 1) v += __shfl_xor(v, o);
    return v; }
__device__ __forceinline__ float wave_max(float v) {
#pragma unroll
    for (int o = 1; o < 64; o <<= 1) v = fmaxf(v, __shfl_xor(v, o));
    return v; }
__device__ __forceinline__ float wave_incl_scan(float v, int lane) {
#pragma unroll
    for (int o = 1; o < 64; o <<= 1) { const float t = __shfl_up(v, o); if (lane >= o) v += t; }
    return v; }
__device__ __forceinline__ float silu(float x) { return x * __builtin_amdgcn_rcpf(1.f + __builtin_amdgcn_exp2f(-1.4426950408889634f * x)); }
__device__ __forceinline__ float row_rs(const float* ssq, int row) { return rsqrtf(ssq[(unsigned)row] * (1.f / DM) + EPS); }

using pg8::Unit;
struct EpiIn {
    static constexpr bool PERM = true, AFTER_DRAIN = false;
    const float* ssq; bf16_t* zb; bf16_t* x1; float* dtr;
    __device__ __forceinline__ void operator()(const f32x4 (&acc)[2][2][4][2], const Unit& u, int wr, int wc, int fr, int fq) const {
#pragma unroll
        for (int ai = 0; ai < 2; ++ai)
#pragma unroll
            for (int m = 0; m < 4; ++m) { const int row = u.pm * 256 + ai * 128 + wr * 64 + m * 16 + fr; const float rs = row_rs(ssq, row);
#pragma unroll
                for (int bj = 0; bj < 2; ++bj) { const int col = u.pn * 256 + bj * 128 + wc * 32 + 8 * fq; const f32x4 v0 = acc[ai][bj][m][0] * rs, v1 = acc[ai][bj][m][1] * rs;
                    u32x4 w; w.x = pk2(v0[0], v0[1]); w.y = pk2(v0[2], v0[3]); w.z = pk2(v1[0], v1[1]); w.w = pk2(v1[2], v1[3]);
                    if (u.pn < 8) *(u32x4*)(zb + (size_t)row * DI + col) = w;
                    else if (u.pn < 20) *(u32x4*)(x1 + (size_t)row * CONVD + (col - DI)) = w;
                    else if (col < NIN) { float* d = dtr + (size_t)row * 32 + (col - DI - CONVD); *(f32x4*)d = v0; *(f32x4*)(d + 4) = v1; } } }
    }
};
struct EpiRes {
    static constexpr bool PERM = true, AFTER_DRAIN = false;
    float* hf; bf16_t* hb; float* ssq; const float* xin;
    __device__ __forceinline__ void operator()(const f32x4 (&acc)[2][2][4][2], const Unit& u, int wr, int wc, int fr, int fq) const {
#pragma unroll
        for (int ai = 0; ai < 2; ++ai)
#pragma unroll
            for (int m = 0; m < 4; ++m) { const int row = u.pm * 256 + ai * 128 + wr * 64 + m * 16 + fr; float sq = 0.f;
#pragma unroll
                for (int bj = 0; bj < 2; ++bj) { const int col = u.pn * 256 + bj * 128 + wc * 32 + 8 * fq; bf16_t* hp = hb + (size_t)row * DM + col;
                    f32x4 v0, v1;
                    if (xin) { const float* rp = xin + (size_t)row * DM + col; v0 = *(const f32x4*)rp; v1 = *(const f32x4*)(rp + 4); }
                    else { float f[8]; unpack8(*(const u32x4*)hp, f); v0 = (f32x4){f[0], f[1], f[2], f[3]}; v1 = (f32x4){f[4], f[5], f[6], f[7]}; }
                    v0 += acc[ai][bj][m][0]; v1 += acc[ai][bj][m][1];
                    u32x4 w; w.x = pk2(v0[0], v0[1]); w.y = pk2(v0[2], v0[3]); w.z = pk2(v1[0], v1[1]); w.w = pk2(v1[2], v1[3]);
                    *(u32x4*)hp = w;
                    sq += (v0[0] * v0[0] + v0[1] * v0[1]) + (v0[2] * v0[2] + v0[3] * v0[3]) + (v1[0] * v1[0] + v1[1] * v1[1]) + (v1[2] * v1[2] + v1[3] * v1[3]); }
                sq += __shfl_xor(sq, 16); sq += __shfl_xor(sq, 32);
                if (fq == 0) atomicAdd(ssq + row, sq); }
    }
};
struct EpiUp {
    static constexpr bool PERM = true, AFTER_DRAIN = false;
    const float* ssq; bf16_t* up;
    __device__ __forceinline__ void operator()(const f32x4 (&acc)[2][2][4][2], const Unit& u, int wr, int wc, int fr, int fq) const {
#pragma unroll
        for (int ai = 0; ai < 2; ++ai)
#pragma unroll
            for (int m = 0; m < 4; ++m) { const int row = u.pm * 256 + ai * 128 + wr * 64 + m * 16 + fr; const float rs = row_rs(ssq, row);
#pragma unroll
                for (int bj = 0; bj < 2; ++bj) { const int col = u.pn * 256 + bj * 128 + wc * 32 + 8 * fq; const f32x4 v0 = acc[ai][bj][m][0] * rs, v1 = acc[ai][bj][m][1] * rs;
                    u32x4 w; w.x = pk2(v0[0], v0[1]); w.y = pk2(v0[2], v0[3]); w.z = pk2(v1[0], v1[1]); w.w = pk2(v1[2], v1[3]);
                    *(u32x4*)(up + (size_t)row * NUP + col) = w; } }
    }
};
struct EpiQkv {
    static constexpr bool PERM = true, AFTER_DRAIN = false;
    const float* ssq; bf16_t* qb; bf16_t* kb; bf16_t* vb; float* out; const float* bfv;
    __device__ __forceinline__ void operator()(const f32x4 (&acc)[2][2][4][2], const Unit& u, int wr, int wc, int fr, int fq) const {
        const int sec = u.pn >> 2;
#pragma unroll
        for (int ai = 0; ai < 2; ++ai)
#pragma unroll
            for (int m = 0; m < 4; ++m) { const int row = u.pm * 256 + ai * 128 + wr * 64 + m * 16 + fr; float rs = row_rs(ssq, row); if (sec == 0) rs *= C2Q;
#pragma unroll
                for (int bj = 0; bj < 2; ++bj) { const int col = (u.pn & 3) * 256 + bj * 128 + wc * 32 + 8 * fq; const f32x4 v0 = acc[ai][bj][m][0] * rs, v1 = acc[ai][bj][m][1] * rs;
                    u32x4 w; w.x = pk2(v0[0], v0[1]); w.y = pk2(v0[2], v0[3]); w.z = pk2(v1[0], v1[1]); w.w = pk2(v1[2], v1[3]);
                    if (sec == 0) *(u32x4*)(qb + (size_t)row * DM + col) = w;
                    else if (sec < 3) { *(u32x4*)((sec == 1 ? kb : vb) + (size_t)row * DM + col) = w;
                        float* o = (row < MP) ? out + (sec == 1 ? O_PK : O_PV) + (size_t)row * DM + col : out + (sec == 1 ? O_SK : O_SV) + (size_t)(row - MP) * DM + col;
                        *(f32x4*)o = v0; *(f32x4*)(o + 4) = v1; }
                    else if (col < NH) { float* o = (row < MP) ? out + O_PLF + (size_t)row * NH + col : out + O_SLF + (size_t)(row - MP) * NH + col;
                        float r[8] = {v0[0], v0[1], v0[2], v0[3], v1[0], v1[1], v1[2], v1[3]};
#pragma unroll
                        for (int e = 0; e < 8; ++e) { const float x = r[e] + bfv[col + e]; r[e] = fminf(x, 0.f) - log1pf(__expf(-fabsf(x))); }
                        *(f32x4*)o = (f32x4){r[0], r[1], r[2], r[3]}; *(f32x4*)(o + 4) = (f32x4){r[4], r[5], r[6], r[7]}; } } }
    }
};

__host__ __device__ __forceinline__ int up_pos(int f) { const int n = f >= DFF ? 1 : 0, ch = f - n * DFF; return 256 * (ch >> 7) + 128 * ((ch >> 6) & 1) + 32 * ((ch >> 4) & 3) + 8 * ((ch >> 2) & 3) + 4 * n + (ch & 3); }
template <int CTRL> __device__ __forceinline__ float dpp_(float old, float src) { return __int_as_float(__builtin_amdgcn_update_dpp(__float_as_int(old), __float_as_int(src), CTRL, 0xf, 0xf, false)); }
struct EpiUpF {
    static constexpr bool PERM = true, AFTER_DRAIN = false;
    const float* ssq; bf16_t* g; float* edge; const float* cw; const float* cb;
    __device__ __forceinline__ void operator()(f32x4 (&ac)[2][2][4][2], const Unit& u, int wr, int wc, int fr, int fq) const {
        float rsv[2][4];
#pragma unroll
        for (int ai = 0; ai < 2; ++ai)
#pragma unroll
            for (int mm = 0; mm < 4; ++mm) rsv[ai][mm] = row_rs(ssq, u.pm * 256 + ai * 128 + wr * 64 + mm * 16 + fr);
        f32x4 wq[2][4], wn[2][4];
#define LDW(dst, bjx) do { const int chx_ = 128 * u.pn + 64 * (bjx) + 16 * wc + 4 * fq; _Pragma("unroll") for (int hv_ = 0; hv_ < 2; ++hv_) { dst[hv_][0] = *(const f32x4*)(cw + (unsigned)(hv_ * DFF + chx_)); dst[hv_][1] = *(const f32x4*)(cw + (unsigned)(NUP + hv_ * DFF + chx_)); dst[hv_][2] = *(const f32x4*)(cw + (unsigned)(2 * NUP + hv_ * DFF + chx_)); dst[hv_][3] = *(const f32x4*)(cb + (unsigned)(hv_ * DFF + chx_)); } } while (0)
        LDW(wq, 0);
#pragma unroll
        for (int bj = 0; bj < 2; ++bj) { const int ch0 = 128 * u.pn + 64 * bj + 16 * wc + 4 * fq;
#pragma unroll
            for (int ai = 0; ai < 2; ++ai) { if (bj == 0 && ai == 1) { asm volatile("" ::: "memory"); LDW(wn, 1); }
                if (bj == 1 && ai == 0) {
#pragma unroll
                    for (int hv_ = 0; hv_ < 2; ++hv_)
#pragma unroll
                        for (int t_ = 0; t_ < 4; ++t_) wq[hv_][t_] = wn[hv_][t_]; }
                const int blk = u.pm * 4 + ai * 2 + wr; const int rowb = u.pm * 256 + ai * 128 + wr * 64 + fr;
#pragma unroll
                for (int mm = 0; mm < 4; ++mm) { ac[ai][bj][mm][0] *= rsv[ai][mm]; ac[ai][bj][mm][1] *= rsv[ai][mm]; }
                if (fr < 2 || fr >= 14) { float* ep = edge + (unsigned)((blk * 4 + ((fr + 2) & 3)) * NUP + 2 * ch0); const bool lo_ = fr < 2;
                    f32x4 s0, s1;
#pragma unroll
                    for (int e = 0; e < 4; ++e) { s0[e] = lo_ ? ac[ai][bj][0][0][e] : ac[ai][bj][3][0][e]; s1[e] = lo_ ? ac[ai][bj][0][1][e] : ac[ai][bj][3][1][e]; }
                    *(f32x4*)ep = s0; *(f32x4*)(ep + 4) = s1; }
#pragma unroll
                for (int hv = 0; hv < 2; ++hv)
#pragma unroll
                    for (int e = 0; e < 4; ++e) { const float w0 = wq[hv][0][e], w1 = wq[hv][1][e], w2 = wq[hv][2][e], bq = wq[hv][3][e];
#pragma unroll
                        for (int mm = 3; mm >= 0; --mm) { const float uc = ac[ai][bj][mm][hv][e]; const float pc = mm > 0 ? ac[ai][bj][mm > 0 ? mm - 1 : 0][hv][e] : 0.f;
                            const float q1 = dpp_<0x111>(dpp_<0x121>(0.f, pc), uc), q2 = dpp_<0x112>(dpp_<0x122>(0.f, pc), uc);
                            const float cc_ = bq + w0 * q2 + w1 * q1 + w2 * uc;
                            ac[ai][bj][mm][hv][e] = hv == 0 ? silu(cc_) : cc_; } }
#pragma unroll
                for (int mm = 0; mm < 4; ++mm) if (mm > 0 || fr >= 2) { const f32x4 go = ac[ai][bj][mm][0] * ac[ai][bj][mm][1]; *(u32x2*)(g + (unsigned)((rowb + 16 * mm) * DFF + ch0)) = (u32x2){pk2(go[0], go[1]), pk2(go[2], go[3])}; } } }
    }
};
typedef unsigned v4u __attribute__((ext_vector_type(4)));
#define XB_TMO      128
#define XB_XCNT(j)  (256  + 64 * (j))
#define XB_XSUB(j)  (1280 + 64 * (j))
#define XB_XGEN(j)  (2304 + 64 * (j))
#define XB_TOP      3328
#define XB_TOPGEN   3392
#define XCD_BAR_WORDS 3456
#define XB_SPIN_CAP (1u << 18)

__device__ __forceinline__ unsigned xb_ld(unsigned* p)              { return __hip_atomic_load(p, __ATOMIC_RELAXED, __HIP_MEMORY_SCOPE_AGENT); }
__device__ __forceinline__ unsigned xb_add(unsigned* p, unsigned v) { return __hip_atomic_fetch_add(p, v, __ATOMIC_RELAXED, __HIP_MEMORY_SCOPE_AGENT); }
__device__ __forceinline__ unsigned xb_xcc_id() { return (unsigned)__builtin_amdgcn_s_getreg((3 << 11) | 20) & 0xFu; }
#define XB_SPIN(cond, bar) do { unsigned _sp = 0; while (cond) { __builtin_amdgcn_s_sleep(1); \
    if ((++_sp & 255u) == 0u) { if (xb_ld(&(bar)[XB_TMO])) break; if (_sp > XB_SPIN_CAP) { atomicAdd(&(bar)[XB_TMO], 1u); break; } } } } while (0)

struct XcdBarrier {
    unsigned* bar; unsigned x;
    volatile LAS unsigned* st;
};

__device__ __forceinline__ XcdBarrier xcd_barrier_post(unsigned* bar, volatile LAS unsigned* st) {
    XcdBarrier b; b.bar = bar; b.x = xb_xcc_id(); b.st = st;
    if (threadIdx.x == 0) (void)xb_add(&bar[XB_XCNT(b.x)], 1u);
    return b;
}
__device__ __forceinline__ void xcd_barrier_complete(unsigned* bar, unsigned x, unsigned& nloc, unsigned& nx) {
    const unsigned G = gridDim.x * gridDim.y * gridDim.z;
    unsigned sum, cnt, mine, sp = 0u;
    for (;;) {
        sum = 0u; cnt = 0u; mine = 0u;
#pragma unroll
        for (unsigned j = 0; j < 16; ++j) { const unsigned c = xb_ld(&bar[XB_XCNT(j)]); sum += c; cnt += (c > 0u) ? 1u : 0u; mine = (j == x) ? c : mine; }
        if (sum == G) break;
        __builtin_amdgcn_s_sleep(1);
        if ((++sp & 255u) == 0u) { if (xb_ld(&bar[XB_TMO])) break; if (sp > XB_SPIN_CAP) { atomicAdd(&bar[XB_TMO], 1u); break; } }
    }
    nloc = mine > 0u ? mine : 1u; nx = cnt > 0u ? cnt : 1u;
}

__device__ __forceinline__ void xcd_barrier(const XcdBarrier& b) {
    asm volatile("s_waitcnt vmcnt(0)" ::: "memory");
    __syncthreads();
    if (threadIdx.x == 0) {
        unsigned* bar = b.bar;
        __builtin_amdgcn_s_waitcnt(0);
        unsigned nloc = b.st[0], nx = b.st[1];
        if (nloc == 0u) { xcd_barrier_complete(bar, b.x, nloc, nx); b.st[0] = nloc; b.st[1] = nx; }
        const unsigned old = xb_add(&bar[XB_XSUB(b.x)], 1u);
        const unsigned gen = old / nloc;
        if (old + 1u == (gen + 1u) * nloc) {
            __builtin_amdgcn_fence(__ATOMIC_RELEASE, "agent");
            asm volatile("s_waitcnt vmcnt(0)" ::: "memory");
            const unsigned og = xb_add(&bar[XB_TOP], 1u);
            const unsigned tg = og / nx;
            if (og + 1u == (tg + 1u) * nx) xb_add(&bar[XB_TOPGEN], 1u);
            else XB_SPIN(xb_ld(&bar[XB_TOPGEN]) == tg, bar);
            __builtin_amdgcn_fence(__ATOMIC_ACQUIRE, "agent");
            xb_add(&bar[XB_XGEN(b.x)], 1u);
            asm volatile("s_waitcnt vmcnt(0)" ::: "memory");
        } else {
            XB_SPIN(xb_ld(&bar[XB_XGEN(b.x)]) == gen, bar);
            __builtin_amdgcn_fence(__ATOMIC_ACQUIRE, "agent");
            asm volatile("s_waitcnt vmcnt(0)" ::: "memory");
        }
    }
    __syncthreads();
}
struct Ctx { LAS unsigned char* lds; int tid, lane, wave, G, bid; const float* const* in; float* out; unsigned char* ws; };

template <bool UPPERM = false> __device__ __forceinline__ void p0_transpose_item(const float* W, const float* nw, int K, int N, bf16_t* WT, int row_off, LAS float* scr, int item, int lane) {
    const int nblk = N / 32, kb = item / nblk, nb = item % nblk, k0 = 64 * kb, n0 = 32 * nb;
    float wv[32];
#pragma unroll
    for (int i = 0; i < 32; ++i) { const int kk = 2 * i + (lane >> 5); wv[i] = W[(size_t)(k0 + kk) * N + n0 + (lane & 31)]; }
#pragma unroll
    for (int i = 0; i < 32; ++i) { const int kk = 2 * i + (lane >> 5); const float s = nw ? nw[k0 + kk] : 1.f; scr[kk * 33 + (lane & 31)] = wv[i] * s; }
    asm volatile("s_waitcnt lgkmcnt(0)" ::: "memory");
    const int c = lane & 7;
#pragma unroll
    for (int j = 0; j < 4; ++j) { const int n = (lane >> 3) + 8 * j; const LAS float* s = scr + (8 * c) * 33 + n;
        u32x4 o; o.x = pk2(s[0 * 33], s[1 * 33]); o.y = pk2(s[2 * 33], s[3 * 33]); o.z = pk2(s[4 * 33], s[5 * 33]); o.w = pk2(s[6 * 33], s[7 * 33]);
        const int drow = UPPERM ? up_pos(n0 + n) : row_off + n0 + n;
        *(u32x4*)(WT + (size_t)drow * K + k0 + 8 * c) = o; }
    asm volatile("s_waitcnt lgkmcnt(0)" ::: "memory");
}
constexpr int I_IN = (DM / 64) * (NIN / 32), I_OUT = (DI / 64) * (DM / 32), I_UP = (DM / 64) * (NUP / 32), I_DN = (DFF / 64) * (DM / 32), I_SQ = (DM / 64) * (DM / 32);
constexpr int IT_OUT = I_IN, IT_UP0 = IT_OUT + I_OUT, IT_UP1 = IT_UP0 + I_UP, IT_DN0 = IT_UP1 + I_UP, IT_DN1 = IT_DN0 + I_DN, IT_Q = IT_DN1 + I_DN, IT_K = IT_Q + I_SQ, IT_V = IT_K + I_SQ, IT_O = IT_V + I_SQ, IT_END = IT_O + I_SQ;
__device__ __forceinline__ void convert_items(const Ctx& C, int vi, int vn, int lo, int hi) {
    if (vi < 0) return;
    LAS float* scr = (LAS float*)(C.lds + C.wave * 16384);
    unsigned char* ws = C.ws;
    bf16_t* Win = (bf16_t*)(ws + WS_WIN); bf16_t* Wout = (bf16_t*)(ws + WS_WOUT); bf16_t* Wup = (bf16_t*)(ws + WS_WUP); bf16_t* Wdn = (bf16_t*)(ws + WS_WDN);
    bf16_t* Wq = (bf16_t*)(ws + WS_WQ); bf16_t* Wo = (bf16_t*)(ws + WS_WO);
    for (int it = lo + vi * NW_ + C.wave; it < hi; it += vn * NW_) {
        int r = it;
        if (r < I_IN) { p0_transpose_item(C.in[10], C.in[8], DM, NIN, Win, 0, scr, r, C.lane); continue; } r -= I_IN;
        if (r < I_OUT) { p0_transpose_item(C.in[17], nullptr, DI, DM, Wout, 0, scr, r, C.lane); continue; } r -= I_OUT;
        if (r < I_UP) { p0_transpose_item<true>(C.in[25], C.in[9], DM, NUP, Wup, 0, scr, r, C.lane); continue; } r -= I_UP;
        if (r < I_UP) { p0_transpose_item<true>(C.in[25] + (size_t)DM * NUP, C.in[9] + DM, DM, NUP, Wup + (size_t)NUP * DM, 0, scr, r, C.lane); continue; } r -= I_UP;
        if (r < I_DN) { p0_transpose_item(C.in[28], nullptr, DFF, DM, Wdn, 0, scr, r, C.lane); continue; } r -= I_DN;
        if (r < I_DN) { p0_transpose_item(C.in[28] + (size_t)DFF * DM, nullptr, DFF, DM, Wdn + (size_t)DM * DFF, 0, scr, r, C.lane); continue; } r -= I_DN;
        if (r < I_SQ) { p0_transpose_item(C.in[23], C.in[8] + DM, DM, DM, Wq, 0, scr, r, C.lane); continue; } r -= I_SQ;
        if (r < I_SQ) { p0_transpose_item(C.in[19], C.in[18], DM, DM, Wq, DM, scr, r, C.lane); continue; } r -= I_SQ;
        if (r < I_SQ) { p0_transpose_item(C.in[20], C.in[18], DM, DM, Wq, 2 * DM, scr, r, C.lane); continue; } r -= I_SQ;
        p0_transpose_item(C.in[24], nullptr, DM, DM, Wo, 0, scr, r, C.lane);
    }
}
__device__ __forceinline__ void idle_vgrid(const Ctx& C, int nunits, int& vi, int& vn) { const int ex = nunits % C.G; if (ex == 0) { vi = C.bid; vn = C.G; } else { vn = C.G - ex; vi = C.bid >= ex ? C.bid - ex : -1; } }
__device__ __forceinline__ void phase_prologue(const Ctx& C) {
    const int gw = C.bid * NW_ + C.wave, NGW = C.G * NW_;
    unsigned char* ws = C.ws;
    bf16_t* Win = (bf16_t*)(ws + WS_WIN); bf16_t* Wq = (bf16_t*)(ws + WS_WQ);
    convert_items(C, C.bid, C.G, 0, IT_UP0);
    const int gt = C.bid * NT_ + C.tid, NGT = C.G * NT_;
    for (int i = gt; i < 16 * DM; i += NGT) { const int n = i / DM, k = i % DM; Wq[(size_t)(3 * DM + n) * DM + k] = (bf16_t)f2bf(C.in[21][(size_t)k * 16 + n] * C.in[18][k]); }
    for (int i = gt; i < (NQ - 3 * DM - 16) * DM / 8; i += NGT) ((u32x4*)(Wq + (size_t)(3 * DM + 16) * DM))[i] = (u32x4){0u, 0u, 0u, 0u};
    for (int i = gt; i < (NIN_PAD - NIN) * DM / 8; i += NGT) ((u32x4*)(Win + (size_t)NIN * DM))[i] = (u32x4){0u, 0u, 0u, 0u};
    for (int i = gt; i < 3 * M; i += NGT) ((float*)(ws + WS_SSQ))[M + i] = 0.f;
    float* ssq0 = (float*)(ws + WS_SSQ); bf16_t* hb = (bf16_t*)(ws + WS_HB);
    for (int m0 = gw * 4; m0 < M; m0 += NGW * 4) {
        f32x4 v[4][4];
#pragma unroll
        for (int r = 0; r < 4; ++r) { const int m = m0 + r; const float* xr = (m < MP) ? C.in[0] + (size_t)m * DM : C.in[1] + (size_t)(m - MP) * DM;
#pragma unroll
            for (int j = 0; j < 4; ++j) v[r][j] = ((const f32x4*)xr)[C.lane + 64 * j]; }
#pragma unroll
        for (int r = 0; r < 4; ++r) { const int m = m0 + r; float s = 0.f;
#pragma unroll
            for (int j = 0; j < 4; ++j) { const f32x4 x = v[r][j]; s += (x.x * x.x + x.y * x.y) + (x.z * x.z + x.w * x.w);
                ((u32x2*)(hb + (size_t)m * DM))[C.lane + 64 * j] = (u32x2){pk2(x.x, x.y), pk2(x.z, x.w)}; }
            s = wave_sum(s);
            if (C.lane == 0) ssq0[m] = s; }
    }
}

__device__ __forceinline__ void phase_mconv(const Ctx& C) {
    const bf16_t* x1 = (const bf16_t*)(C.ws + WS_X1); bf16_t* x2 = (bf16_t*)(C.ws + WS_X2); float* dt = (float*)(C.ws + WS_DT);
    const float* cw = C.in[11]; const float* cbias = C.in[12]; const float* st = C.in[3];
    const int gt = C.bid * NT_ + C.tid, NGT = C.G * NT_;
    constexpr int NCG = CONVD / 8, NRB = M / 16;
    for (int it = gt; it < NRB * NCG; it += NGT) {
        const int rb = it / NCG, c0 = (it % NCG) * 8, m0 = rb * 16;
        float w[4][8], bb[8], h0[8], h1[8], h2[8];
#pragma unroll
        for (int t = 0; t < 4; ++t) { const f32x4 a = *(const f32x4*)(cw + t * CONVD + c0), b = *(const f32x4*)(cw + t * CONVD + c0 + 4); w[t][0] = a.x; w[t][1] = a.y; w[t][2] = a.z; w[t][3] = a.w; w[t][4] = b.x; w[t][5] = b.y; w[t][6] = b.z; w[t][7] = b.w; }
        { const f32x4 a = *(const f32x4*)(cbias + c0), b = *(const f32x4*)(cbias + c0 + 4); bb[0] = a.x; bb[1] = a.y; bb[2] = a.z; bb[3] = a.w; bb[4] = b.x; bb[5] = b.y; bb[6] = b.z; bb[7] = b.w; }
        if (rb >= MP / 16) { const float* sp = st + (size_t)(rb - MP / 16) * 3 * CONVD + c0;
#pragma unroll
            for (int e = 0; e < 8; ++e) { h0[e] = sp[e]; h1[e] = sp[CONVD + e]; h2[e] = sp[2 * CONVD + e]; } }
        else if (rb == 0) {
#pragma unroll
            for (int e = 0; e < 8; ++e) { h0[e] = 0.f; h1[e] = 0.f; h2[e] = 0.f; } }
        else { unpack8(*(const u32x4*)(x1 + (size_t)(m0 - 3) * CONVD + c0), h0); unpack8(*(const u32x4*)(x1 + (size_t)(m0 - 2) * CONVD + c0), h1); unpack8(*(const u32x4*)(x1 + (size_t)(m0 - 1) * CONVD + c0), h2); }
        u32x4 rawv[16];
#pragma unroll
        for (int i = 0; i < 16; ++i) rawv[i] = *(const u32x4*)(x1 + (size_t)(m0 + i) * CONVD + c0);
#pragma unroll
        for (int i = 0; i < 16; ++i) { float cur[8], o[8]; unpack8(rawv[i], cur);
#pragma unroll
            for (int e = 0; e < 8; ++e) { const float v = bb[e] + w[0][e] * h0[e] + w[1][e] * h1[e] + w[2][e] * h2[e] + w[3][e] * cur[e]; o[e] = silu(v); h0[e] = h1[e]; h1[e] = h2[e]; h2[e] = cur[e]; }
            *(u32x4*)(x2 + (size_t)(m0 + i) * CONVD + c0) = pack8(o); }
    }
    const float* dtb = C.in[13];
    for (int i = gt; i < M * 32; i += NGT) { const float x = dt[i] + dtb[i & 31]; dt[i] = x > 20.f ? x : log1pf(__expf(x)); }
    for (int i = gt; i < 33 * 3 * CONVD; i += NGT) { const int sq = i / (3 * CONVD), r = i % (3 * CONVD), j = r / CONVD, c = r % CONVD;
        if (sq == 0) C.out[O_PMC + r] = bf1(x1[(size_t)(MP - 3 + j) * CONVD + c]);
        else C.out[O_SMC + (size_t)(sq - 1) * 3 * CONVD + r] = bf1(x1[(size_t)(MP + (sq - 1) * 16 + 13 + j) * CONVD + c]); }
}

__device__ __forceinline__ void phase_fconv(const Ctx& C, int layer) {
    const float* edge = (const float*)(C.ws + WS_EDGE); const bf16_t* up = (const bf16_t*)(C.ws + WS_UPS) - (size_t)MP * NUP; bf16_t* g = (bf16_t*)(C.ws + WS_G);
    const float* cw = C.in[26] + (size_t)layer * 3 * NUP; const float* cbias = C.in[27] + (size_t)layer * NUP; const float* st = C.in[4] + (size_t)layer * NSB * 2 * NUP;
    const int gt = C.bid * NT_ + C.tid, NGT = C.G * NT_;
    constexpr int NC4 = DFF / 4;
    for (int it = gt; it < NCH * 2 * NC4; it += NGT) { const int ch0 = (it % NC4) * 4, br = it / NC4, blk = br >> 1, r = br & 1, pos = up_pos(ch0);
        f32x4 ug, uvl, p1g, p1v, p2g, p2v; const f32x4 z4 = {0.f, 0.f, 0.f, 0.f};
        { const float* e = edge + ((size_t)blk * 4 + 2 + r) * NUP + pos; ug = *(const f32x4*)e; uvl = *(const f32x4*)(e + 4); }
        if (r == 1) { const float* e = edge + ((size_t)blk * 4 + 2) * NUP + pos; p1g = *(const f32x4*)e; p1v = *(const f32x4*)(e + 4); }
        else if (blk > 0) { const float* e = edge + ((size_t)(blk - 1) * 4 + 1) * NUP + pos; p1g = *(const f32x4*)e; p1v = *(const f32x4*)(e + 4); } else { p1g = z4; p1v = z4; }
        if (blk > 0) { const float* e = edge + ((size_t)(blk - 1) * 4 + r) * NUP + pos; p2g = *(const f32x4*)e; p2v = *(const f32x4*)(e + 4); } else { p2g = z4; p2v = z4; }
        const f32x4 w0g = *(const f32x4*)(cw + ch0), w1g = *(const f32x4*)(cw + NUP + ch0), w2g = *(const f32x4*)(cw + 2 * NUP + ch0), bg = *(const f32x4*)(cbias + ch0);
        const f32x4 w0v = *(const f32x4*)(cw + DFF + ch0), w1v = *(const f32x4*)(cw + NUP + DFF + ch0), w2v = *(const f32x4*)(cw + 2 * NUP + DFF + ch0), bv = *(const f32x4*)(cbias + DFF + ch0);
        const f32x4 cg_ = bg + w0g * p2g + w1g * p1g + w2g * ug, cv_ = bv + w0v * p2v + w1v * p1v + w2v * uvl;
        *(u32x2*)(g + (size_t)(64 * blk + r) * DFF + ch0) = (u32x2){pk2(silu(cg_.x) * cv_.x, silu(cg_.y) * cv_.y), pk2(silu(cg_.z) * cv_.z, silu(cg_.w) * cv_.w)}; }
    constexpr int NCG = DFF / 8;
    for (int it = gt; it < (MS / 8) * NCG; it += NGT) {
        const int rb = MP / 8 + it / NCG, c0 = (it % NCG) * 8, m0 = rb * 8;
        const bool sstart = (((m0 - MP) & 15) == 0);
        float o[8][8];
#pragma unroll
        for (int half = 0; half < 2; ++half) {
            const int cc = c0 + half * DFF;
            float w[3][8], bb[8], h0[8], h1[8];
#pragma unroll
            for (int t = 0; t < 3; ++t) { const f32x4 a = *(const f32x4*)(cw + t * NUP + cc), b = *(const f32x4*)(cw + t * NUP + cc + 4); w[t][0] = a.x; w[t][1] = a.y; w[t][2] = a.z; w[t][3] = a.w; w[t][4] = b.x; w[t][5] = b.y; w[t][6] = b.z; w[t][7] = b.w; }
            { const f32x4 a = *(const f32x4*)(cbias + cc), b = *(const f32x4*)(cbias + cc + 4); bb[0] = a.x; bb[1] = a.y; bb[2] = a.z; bb[3] = a.w; bb[4] = b.x; bb[5] = b.y; bb[6] = b.z; bb[7] = b.w; }
            if (sstart) { const float* sp = st + (size_t)((m0 - MP) >> 4) * 2 * NUP + cc;
#pragma unroll
                for (int e = 0; e < 8; ++e) { h0[e] = sp[e]; h1[e] = sp[NUP + e]; } }
            const int pp = up_pos(cc);
#define LD8P(dst, rowp) do { const u32x2 lo_ = *(const u32x2*)((rowp) + pp), hi_ = *(const u32x2*)((rowp) + pp + 8); unpack8((u32x4){lo_.x, lo_.y, hi_.x, hi_.y}, dst); } while (0)
            if (!sstart) { LD8P(h0, up + (size_t)(m0 - 2) * NUP); LD8P(h1, up + (size_t)(m0 - 1) * NUP); }
#pragma unroll
            for (int i = 0; i < 8; ++i) { float cur[8]; LD8P(cur, up + (size_t)(m0 + i) * NUP);
#pragma unroll
                for (int e = 0; e < 8; ++e) { const float v = bb[e] + w[0][e] * h0[e] + w[1][e] * h1[e] + w[2][e] * cur[e]; o[i][e] = half == 0 ? silu(v) : o[i][e] * v; h0[e] = h1[e]; h1[e] = cur[e]; } }
        }
#pragma unroll
        for (int i = 0; i < 8; ++i) *(u32x4*)(g + (size_t)(m0 + i) * DFF + c0) = pack8(o[i]);
    }
    for (int i = gt; i < 33 * 2 * NUP; i += NGT) { const int sq = i / (2 * NUP), r = i % (2 * NUP), j = r / NUP, c = r % NUP;
        if (sq == 0) C.out[O_PFC + (size_t)layer * 2 * NUP + r] = edge[((size_t)(NCH - 1) * 4 + j) * NUP + up_pos(c)];
        else C.out[O_SFC + ((size_t)layer * NSB + (sq - 1)) * 2 * NUP + r] = bf1(up[(size_t)(MP + (sq - 1) * 16 + 14 + j) * NUP + up_pos(c)]); }
#undef LD8P
}

__device__ __forceinline__ void phase_final(const Ctx& C) {
    const int gw = C.bid * NW_ + C.wave, NGW = C.G * NW_; const float* fw = C.in[29]; const bf16_t* hb = (const bf16_t*)(C.ws + WS_HB);
    for (int m0 = gw * 4; m0 < M; m0 += NGW * 4) { u32x4 v[4][2];
#pragma unroll
        for (int r = 0; r < 4; ++r)
#pragma unroll
            for (int j = 0; j < 2; ++j) v[r][j] = ((const u32x4*)(hb + (size_t)(m0 + r) * DM))[C.lane + 64 * j];
#pragma unroll
        for (int r = 0; r < 4; ++r) { float f[2][8]; float s = 0.f;
#pragma unroll
            for (int j = 0; j < 2; ++j) { unpack8(v[r][j], f[j]);
#pragma unroll
                for (int e = 0; e < 8; ++e) s += f[j][e] * f[j][e]; }
            const float rs = rsqrtf(wave_sum(s) * (1.f / DM) + EPS);
#pragma unroll
            for (int j = 0; j < 2; ++j) { const int c0 = 8 * (C.lane + 64 * j); const f32x4 w0 = *(const f32x4*)(fw + c0), w1 = *(const f32x4*)(fw + c0 + 4); float* o = C.out + (size_t)(m0 + r) * DM + c0;
                *(f32x4*)o = (f32x4){f[j][0] * rs * w0.x, f[j][1] * rs * w0.y, f[j][2] * rs * w0.z, f[j][3] * rs * w0.w}; *(f32x4*)(o + 4) = (f32x4){f[j][4] * rs * w1.x, f[j][5] * rs * w1.y, f[j][6] * rs * w1.z, f[j][7] * rs * w1.w}; } }
    }
}
typedef short v4i16_t __attribute__((ext_vector_type(4)));
__device__ __forceinline__ s16x4 vtr(const LAS unsigned char* p) { return __builtin_bit_cast(s16x4, __builtin_amdgcn_ds_read_tr16_b64_v4i16((LAS v4i16_t*)p)); }
__device__ __forceinline__ bf16x8 trfrag(const LAS unsigned char* img, int rs, int k0, int c0, int lane) {
    const int gq = lane >> 4, li = lane & 15, q = li >> 2, p = li & 3;
    const LAS unsigned char* a = img + (k0 + 8 * gq + q) * rs + (c0 + 4 * p) * 2;
    const s16x4 r1 = vtr(a), r2 = vtr(a + 4 * rs);
    return (bf16x8){r1[0], r1[1], r1[2], r1[3], r2[0], r2[1], r2[2], r2[3]};
}
constexpr int RSB = 272, RSX = 144;
constexpr int SSD_UNITS = (NCH + NSB) * 4;
__device__ __forceinline__ void ssd_unit_geom(int unit, int& uc, int& g, int& m0, int& L) { uc = unit >> 2; g = unit & 3; if (uc < NCH) { m0 = 64 * uc; L = 64; } else { m0 = MP + 16 * (uc - NCH); L = 16; } }
__device__ __forceinline__ void ssd_load_tile128(const Ctx& C, LAS unsigned char* dst, const bf16_t* x2, int m0, int L, int col0) {
    const int row = C.tid >> 3;
#pragma unroll
    for (int cc = 0; cc < 2; ++cc) { const int ch = (C.tid & 7) * 2 + cc; u32x4 v = {0u, 0u, 0u, 0u};
        if (row < L) v = *(const u32x4*)(x2 + (size_t)(m0 + row) * CONVD + col0 + 8 * ch);
        *(LAS u32x4*)(dst + row * RSB + 16 * ch) = v; }
}

__device__ __forceinline__ void phase_ssd1(const Ctx& C, int unit_lo, int unit_hi) {
    const bf16_t* x2 = (const bf16_t*)(C.ws + WS_X2); const float* dt = (const float*)(C.ws + WS_DT); bf16_t* st = (bf16_t*)(C.ws + WS_ST); float* dec = (float*)(C.ws + WS_DEC);
    LAS unsigned char* Bs = C.lds; LAS unsigned char* Xs = C.lds + 17408 + C.wave * 13824; LAS float* sc = (LAS float*)(Xs + 9216); LAS unsigned char* stg = Xs + 9472;
    const int lane = C.lane, gq = lane >> 4, li = lane & 15;
    for (int unit = unit_lo + C.bid; unit < unit_hi; unit += C.G) {
        int uc, g, m0, L; ssd_unit_geom(unit, uc, g, m0, L);
        const int h = 8 * g + C.wave;
        ssd_load_tile128(C, Bs, x2, m0, L, DI + 128 * g);
        const float Ah = -__expf(C.in[14][h]);
        const float dtv = (lane < L) ? dt[(size_t)(m0 + lane) * 32 + h] : 0.f;
        u32x4 xr[8];
#pragma unroll
        for (int i = 0; i < 8; ++i) { const int srow = 8 * i + (lane >> 3), pc = lane & 7; xr[i] = (u32x4){0u, 0u, 0u, 0u};
            if (srow < L) xr[i] = *(const u32x4*)(x2 + (size_t)(m0 + srow) * CONVD + 64 * h + 8 * pc); }
        int ls_ = lane; asm volatile("" : "+v"(ls_)); const float acum = wave_incl_scan(dtv * Ah, ls_); const float last = __shfl(acum, 63);
        sc[lane] = dtv * __expf(last - acum);
        asm volatile("s_waitcnt lgkmcnt(0)" ::: "memory");
#pragma unroll
        for (int i = 0; i < 8; ++i) { const int srow = 8 * i + (lane >> 3), pc = lane & 7;
            float f[8]; unpack8(xr[i], f); const float s = sc[srow];
#pragma unroll
            for (int e = 0; e < 8; ++e) f[e] *= s;
            *(LAS u32x4*)(Xs + srow * RSX + 16 * pc) = pack8(f); }
        __syncthreads();
        const float elast = __expf(last);
#pragma unroll 1
        for (int pt = 0; pt < 4; ++pt) {
            const bf16x8 xf0 = trfrag(Xs, RSX, 0, 16 * pt, lane), xf1 = trfrag(Xs, RSX, 32, 16 * pt, lane);
            f32x4 acc[8];
#pragma unroll
            for (int nt = 0; nt < 8; ++nt) { acc[nt] = (f32x4){0.f, 0.f, 0.f, 0.f};
                const bf16x8 af0 = trfrag(Bs, RSB, 0, 16 * nt, lane), af1 = trfrag(Bs, RSB, 32, 16 * nt, lane);
                acc[nt] = __builtin_amdgcn_mfma_f32_16x16x32_bf16(af0, xf0, acc[nt], 0, 0, 0); acc[nt] = __builtin_amdgcn_mfma_f32_16x16x32_bf16(af1, xf1, acc[nt], 0, 0, 0); }
            if (uc < NCH) {
#pragma unroll
                for (int nt = 0; nt < 8; ++nt) *(LAS u32x2*)(stg + li * RSB + 2 * (16 * nt + 4 * gq)) = (u32x2){pk2(acc[nt][0], acc[nt][1]), pk2(acc[nt][2], acc[nt][3])};
                asm volatile("s_waitcnt lgkmcnt(0)" ::: "memory");
#pragma unroll
                for (int i = 0; i < 4; ++i) { const int row = 4 * i + gq; const u32x4 v = *(const LAS u32x4*)(stg + row * RSB + 16 * li);
                    *(u32x4*)(st + ((size_t)(uc * 32 + h) * 64 + 16 * pt + row) * 128 + 8 * li) = v; }
            } else {
#pragma unroll
                for (int nt = 0; nt < 8; ++nt) { const size_t idx = ((size_t)((uc - NCH) * 32 + h) * 64 + 16 * pt + li) * 128 + 16 * nt + 4 * gq; const f32x4 h0 = *(const f32x4*)(C.in[2] + idx); *(f32x4*)(C.out + O_SSSM + idx) = h0 * elast + acc[nt]; }
            }
        }
        if (uc < NCH && lane == 0) dec[uc * 32 + h] = elast;
        __syncthreads();
    }
}

__device__ __forceinline__ void phase_scan(const Ctx& C) {
    unsigned* st = (unsigned*)(C.ws + WS_ST); const float* dec = (const float*)(C.ws + WS_DEC);
    const int gt = C.bid * NT_ + C.tid, NGT = C.G * NT_;
    for (int e2 = gt; e2 < 32 * 8192 / 2; e2 += NGT) { const int h = e2 >> 12; float r0 = 0.f, r1 = 0.f;
        for (int c0 = 0; c0 < NCH; c0 += 32) { unsigned v[32]; float d[32];
#pragma unroll
            for (int i = 0; i < 32; ++i) { v[i] = st[(size_t)(c0 + i) * 131072 + e2]; d[i] = dec[(c0 + i) * 32 + h]; }
#pragma unroll
            for (int i = 0; i < 32; ++i) { st[(size_t)(c0 + i) * 131072 + e2] = pk2(r0, r1); r0 = r0 * d[i] + bflo(v[i]); r1 = r1 * d[i] + bfhi(v[i]); } }
        *(float2*)(C.out + O_PSSM + 2 * (size_t)e2) = make_float2(r0, r1); }
}

__device__ __forceinline__ void phase_ssd3(const Ctx& C, int unit_lo, int unit_hi, int rot) {
    const bf16_t* x2 = (const bf16_t*)(C.ws + WS_X2); const float* dt = (const float*)(C.ws + WS_DT); const bf16_t* st = (const bf16_t*)(C.ws + WS_ST);
    const bf16_t* zb = (const bf16_t*)(C.ws + WS_ZB); bf16_t* yb = (bf16_t*)(C.ws + WS_X1);
    LAS unsigned char* Cs = C.lds; LAS unsigned char* Bs = C.lds + 17408; LAS float* CB = (LAS float*)Bs;
    LAS unsigned char* Xs = C.lds + 34816 + C.wave * 9728; LAS float* ac = (LAS float*)(Xs + 9216); LAS float* ds = ac + 64;
    LAS float* red = (LAS float*)(C.lds + 34816 + 8 * 9728);
    const int lane = C.lane, gq = lane >> 4, li = lane & 15;
    for (int unit = unit_lo + (C.bid + rot) % C.G; unit < unit_hi; unit += C.G) {
        int uc, g, m0, L; ssd_unit_geom(unit, uc, g, m0, L);
        const int h = 8 * g + C.wave;
        ssd_load_tile128(C, Bs, x2, m0, L, DI + 128 * g);
        ssd_load_tile128(C, Cs, x2, m0, L, DI + 512 + 128 * g);
        const float Ah = -__expf(C.in[14][h]);
        const float dtv = (lane < L) ? dt[(size_t)(m0 + lane) * 32 + h] : 0.f;
        int ls_ = lane; asm volatile("" : "+v"(ls_)); const float acum = wave_incl_scan(dtv * Ah, ls_);
        ac[lane] = acum; ds[lane] = dtv;
#pragma unroll
        for (int i = 0; i < 8; ++i) { const int srow = 8 * i + (lane >> 3), pc = lane & 7; u32x4 v = {0u, 0u, 0u, 0u};
            if (srow < L) v = *(const u32x4*)(x2 + (size_t)(m0 + srow) * CONVD + 64 * h + 8 * pc);
            *(LAS u32x4*)(Xs + srow * RSX + 16 * pc) = v; }
        __syncthreads();
        f32x4 accb[2];
#pragma unroll
        for (int i = 0; i < 2; ++i) { const int id = 2 * C.wave + i, tt = id >> 2, sl = id & 3; accb[i] = (f32x4){0.f, 0.f, 0.f, 0.f};
#pragma unroll
            for (int kn = 0; kn < 4; ++kn) { const bf16x8 a = *(const LAS bf16x8*)(Cs + (16 * tt + li) * RSB + (32 * kn + 8 * gq) * 2), b = *(const LAS bf16x8*)(Bs + (16 * sl + li) * RSB + (32 * kn + 8 * gq) * 2);
                accb[i] = __builtin_amdgcn_mfma_f32_16x16x32_bf16(a, b, accb[i], 0, 0, 0); } }
        __syncthreads();
#pragma unroll
        for (int i = 0; i < 2; ++i) { const int id = 2 * C.wave + i, tt = id >> 2, sl = id & 3;
#pragma unroll
            for (int r = 0; r < 4; ++r) CB[(16 * tt + 4 * gq + r) * 68 + 16 * sl + li] = accb[i][r]; }
        __syncthreads();
        f32x4 acc[4][4];
#pragma unroll
        for (int tt = 0; tt < 4; ++tt)
#pragma unroll
            for (int pt = 0; pt < 4; ++pt) acc[tt][pt] = (f32x4){0.f, 0.f, 0.f, 0.f};
#pragma unroll
        for (int pt = 0; pt < 4; ++pt) {
            if (pt == 2) __builtin_amdgcn_sched_barrier(0);
#pragma unroll
            for (int kn = 0; kn < 4; ++kn) { bf16x8 b;
                if (uc < NCH) b = *(const bf16x8*)(st + ((size_t)(uc * 32 + h) * 64 + 16 * pt + li) * 128 + 32 * kn + 8 * gq);
                else { const float* sp = C.in[2] + ((size_t)((uc - NCH) * 32 + h) * 64 + 16 * pt + li) * 128 + 32 * kn + 8 * gq; const f32x4 s0 = *(const f32x4*)sp, s1 = *(const f32x4*)(sp + 4);
                    const u32x4 w = {pk2(s0.x, s0.y), pk2(s0.z, s0.w), pk2(s1.x, s1.y), pk2(s1.z, s1.w)}; b = __builtin_bit_cast(bf16x8, w); }
#pragma unroll
                for (int tt = 0; tt < 4; ++tt) { const bf16x8 a = *(const LAS bf16x8*)(Cs + (16 * tt + li) * RSB + (32 * kn + 8 * gq) * 2); acc[tt][pt] = __builtin_amdgcn_mfma_f32_16x16x32_bf16(a, b, acc[tt][pt], 0, 0, 0); } }
        }
#pragma unroll
        for (int tt = 0; tt < 4; ++tt)
#pragma unroll
            for (int r = 0; r < 4; ++r) { const float e = __expf(ac[16 * tt + 4 * gq + r]);
#pragma unroll
                for (int pt = 0; pt < 4; ++pt) acc[tt][pt][r] *= e; }
        bf16x8 xf[2][4];
#pragma unroll
        for (int ks = 0; ks < 2; ++ks)
#pragma unroll
            for (int pt = 0; pt < 4; ++pt) xf[ks][pt] = trfrag(Xs, RSX, 32 * ks, 16 * pt, lane);
#pragma unroll
        for (int tt = 0; tt < 4; ++tt) { __builtin_amdgcn_sched_barrier(0); const int t = 16 * tt + li; const float at = ac[t];
#pragma unroll
            for (int ks = 0; ks < 2; ++ks) { if (32 * ks > 16 * tt + 15) continue;
                const int s0 = 32 * ks + 8 * gq; float w[8];
                const f32x4 c0 = *(const LAS f32x4*)(CB + t * 68 + s0), c1 = *(const LAS f32x4*)(CB + t * 68 + s0 + 4);
                const f32x4 a0 = *(const LAS f32x4*)(ac + s0), a1 = *(const LAS f32x4*)(ac + s0 + 4), d0 = *(const LAS f32x4*)(ds + s0), d1 = *(const LAS f32x4*)(ds + s0 + 4);
#pragma unroll
                for (int j = 0; j < 4; ++j) { w[j] = (s0 + j <= t) ? c0[j] * __expf(at - a0[j]) * d0[j] : 0.f; w[4 + j] = (s0 + 4 + j <= t) ? c1[j] * __expf(at - a1[j]) * d1[j] : 0.f; }
                const u32x4 wp = pack8(w); const bf16x8 af = __builtin_bit_cast(bf16x8, wp);
#pragma unroll
                for (int pt = 0; pt < 4; ++pt) acc[tt][pt] = __builtin_amdgcn_mfma_f32_16x16x32_bf16(af, xf[ks][pt], acc[tt][pt], 0, 0, 0); } }
        const float Dh = C.in[15][h];
        asm volatile("" ::: "memory"); __builtin_amdgcn_sched_barrier(0);
        u32x4 zr[8];
#pragma unroll
        for (int i = 0; i < 8; ++i) { const int srow = 8 * i + (lane >> 3), pc = lane & 7; zr[i] = (u32x4){0u, 0u, 0u, 0u};
            if (srow < L) zr[i] = *(const u32x4*)(zb + (size_t)(m0 + srow) * DI + 64 * h + 8 * pc); }
        const LAS unsigned char* trb = Xs + (4 * gq + (li >> 2)) * RSX + 8 * (li & 3);
#pragma unroll
        for (int tt = 0; tt < 4; ++tt)
#pragma unroll
            for (int pt = 0; pt < 4; ++pt) { const s16x4 xv = vtr(trb + 16 * tt * RSX + 32 * pt);
#pragma unroll
                for (int r = 0; r < 4; ++r) acc[tt][pt][r] += Dh * bf1((bf16_t)xv[r]); }
        asm volatile("s_waitcnt lgkmcnt(0)" ::: "memory");
#pragma unroll
        for (int i = 0; i < 8; ++i) { const int srow = 8 * i + (lane >> 3), pc = lane & 7; *(LAS u32x4*)(Xs + srow * RSX + 16 * pc) = zr[i]; }
        asm volatile("s_waitcnt lgkmcnt(0)" ::: "memory");
#pragma unroll
        for (int tt = 0; tt < 4; ++tt) { s16x4 zv[4];
#pragma unroll
            for (int pt = 0; pt < 4; ++pt) zv[pt] = vtr(trb + 16 * tt * RSX + 32 * pt);
#pragma unroll
            for (int r = 0; r < 4; ++r) { const int t = 16 * tt + 4 * gq + r; float s = 0.f;
#pragma unroll
                for (int pt = 0; pt < 4; ++pt) { const float z = bf1((bf16_t)zv[pt][r]); const float v = acc[tt][pt][r] * silu(z); acc[tt][pt][r] = v; s += v * v; }
                s += __shfl_xor(s, 1); s += __shfl_xor(s, 2); s += __shfl_xor(s, 4); s += __shfl_xor(s, 8);
                if (li == 0) red[t * 8 + C.wave] = s; } }
        __syncthreads();
        const float* nw = C.in[16];
        float nwv[4];
#pragma unroll
        for (int pt = 0; pt < 4; ++pt) nwv[pt] = nw[64 * h + 16 * pt + li];
#pragma unroll
        for (int tt = 0; tt < 4; ++tt) {
#pragma unroll
            for (int r = 0; r < 4; ++r) { const int t = 16 * tt + 4 * gq + r; const f32x4 q0 = *(const LAS f32x4*)(red + t * 8), q1 = *(const LAS f32x4*)(red + t * 8 + 4);
                const float rs = rsqrtf((((q0.x + q0.y) + (q0.z + q0.w)) + ((q1.x + q1.y) + (q1.z + q1.w))) * (1.f / 512.f) + EPS);
#pragma unroll
                for (int pt = 0; pt < 4; ++pt) *(LAS bf16_t*)(Xs + t * RSX + 2 * (16 * pt + li)) = (bf16_t)f2bf(acc[tt][pt][r] * rs * nwv[pt]); }
            asm volatile("s_waitcnt lgkmcnt(0)" ::: "memory");
#pragma unroll
            for (int i = 0; i < 2; ++i) { const int srow = 16 * tt + 8 * i + (lane >> 3), pc = lane & 7;
                if (srow < L) *(u32x4*)(yb + (size_t)(m0 + srow) * DI + 64 * h + 8 * pc) = *(const LAS u32x4*)(Xs + srow * RSX + 16 * pc); }
            __builtin_amdgcn_sched_barrier(0);
        }
        __syncthreads();
    }
}

__device__ __forceinline__ void phase_cumsum(const Ctx& C) {
    float* cb = (float*)(C.ws + WS_CB); float* cs = (float*)(C.ws + WS_CS); LAS float* wt = (LAS float*)C.lds;
    for (int h = C.bid; h < NH; h += C.G) {
        const float* lf = C.out + O_PLF; float v[32]; float s = 0.f;
#pragma unroll
        for (int i = 0; i < 32; ++i) { v[i] = lf[(size_t)(32 * C.tid + i) * NH + h]; s += v[i]; }
        const float inc = wave_incl_scan(s, C.lane);
        if (C.lane == 63) wt[C.wave] = inc;
        __syncthreads();
        float base = inc - s;
#pragma unroll
        for (int w = 0; w < 8; ++w) if (w < C.wave) base += wt[w];
        float run = base;
#pragma unroll
        for (int i = 0; i < 32; ++i) { run += v[i]; cb[(size_t)h * MP + 32 * C.tid + i] = -run * LOG2E; }
        __syncthreads();
    }
    const int gw = C.bid * NW_ + C.wave, NGW = C.G * NW_;
    for (int idx = gw; idx < NSB * NH; idx += NGW) { const int b = idx >> 4, h = idx & 15; float v[17]; float s = 0.f;
#pragma unroll
        for (int i = 0; i < 17; ++i) { const int k = 17 * C.lane + i; float x = 0.f;
            if (k < PAST) x = C.in[7][((size_t)b * PAST + k) * NH + h]; else if (k < KL) x = C.out[O_SLF + ((size_t)b * SL + (k - PAST)) * NH + h];
            v[i] = x; s += x; }
        float run = wave_incl_scan(s, C.lane) - s;
#pragma unroll
        for (int i = 0; i < 17; ++i) { const int k = 17 * C.lane + i; run += v[i]; if (k < KL) cs[(size_t)idx * KL + k] = -run * LOG2E; } }
}

__device__ __forceinline__ void phase_attn_sample(const Ctx& C) {
    bf16_t* Qb = (bf16_t*)(C.ws + WS_QB); const bf16_t* Kb = (const bf16_t*)(C.ws + WS_KB); const bf16_t* Vb = (const bf16_t*)(C.ws + WS_VB); const float* cs = (const float*)(C.ws + WS_CS);
    LAS float* qs = (LAS float*)C.lds; LAS float* pbuf = (LAS float*)(C.lds + 4096) + C.wave * 1024; LAS float* comb = (LAS float*)(C.lds + 36864); LAS float* ml = (LAS float*)(C.lds + 69632);
    const int lane = C.lane;
    for (int unit = C.bid; unit < NSB * NH; unit += C.G) { const int b = unit >> 4, h = unit & 15;
        for (int i = C.tid; i < 1024; i += NT_) qs[i] = bf1(Qb[(size_t)(MP + 16 * b + (i >> 6)) * DM + 64 * h + (i & 63)]);
        __syncthreads();
        float m[16], l[16], o[16];
#pragma unroll
        for (int q = 0; q < 16; ++q) { m[q] = -1e30f; l[q] = 0.f; o[q] = 0.f; }
        for (int batch = C.wave; batch < 17; batch += 8) {
            const int key = batch * 64 + lane; const bool valid = key < KL; const int kc = valid ? key : KL - 1;
            float s[16];
#pragma unroll
            for (int q = 0; q < 16; ++q) s[q] = 0.f;
            if (batch < PAST / 64) {
                const float* kp = C.in[5] + (((size_t)b * PAST + kc) * NH + h) * 64;
#pragma unroll 4
                for (int dc = 0; dc < 16; ++dc) { const f32x4 kv = ((const f32x4*)kp)[dc];
#pragma unroll
                    for (int q = 0; q < 16; ++q) { const f32x4 qv = *(const LAS f32x4*)(qs + q * 64 + 4 * dc); s[q] += (kv.x * qv.x + kv.y * qv.y) + (kv.z * qv.z + kv.w * qv.w); } }
            } else {
                const bf16_t* kpn = Kb + (unsigned)((MP + b * SL + (kc - PAST)) * DM + 64 * h);
#pragma unroll 4
                for (int dc = 0; dc < 16; ++dc) { const u32x2 kw = ((const u32x2*)kpn)[dc]; const f32x4 kv = {bflo(kw.x), bfhi(kw.x), bflo(kw.y), bfhi(kw.y)};
#pragma unroll
                    for (int q = 0; q < 16; ++q) { const f32x4 qv = *(const LAS f32x4*)(qs + q * 64 + 4 * dc); s[q] += (kv.x * qv.x + kv.y * qv.y) + (kv.z * qv.z + kv.w * qv.w); } }
            }
            const float bias = cs[(size_t)unit * KL + kc];
#pragma unroll
            for (int q = 0; q < 16; ++q) { const bool ok = valid && (kc < PAST || kc - PAST <= q); const float sv = ok ? s[q] + bias : -1e30f;
                const float mn = fmaxf(m[q], wave_max(sv)); const float p = ok ? __builtin_amdgcn_exp2f(sv - mn) : 0.f; const float scl = __builtin_amdgcn_exp2f(m[q] - mn);
                l[q] = l[q] * scl + wave_sum(p); o[q] *= scl; m[q] = mn; pbuf[lane * 16 + q] = p; }
            asm volatile("s_waitcnt lgkmcnt(0)" ::: "memory");
            const int jmax = min(64, KL - batch * 64);
            for (int j0 = 0; j0 < jmax; j0 += 8) { float vv[8];
#pragma unroll
                for (int u = 0; u < 8; ++u) { const int kj = batch * 64 + j0 + u;
                    vv[u] = (kj < PAST) ? C.in[6][(((size_t)b * PAST + kj) * NH + h) * 64 + lane] : bf1(Vb[(unsigned)((MP + b * SL + (kj - PAST)) * DM + 64 * h + lane)]); }
#pragma unroll
                for (int u = 0; u < 8; ++u) {
#pragma unroll
                    for (int q4 = 0; q4 < 4; ++q4) { const f32x4 p4 = *(const LAS f32x4*)(pbuf + (j0 + u) * 16 + 4 * q4); o[4 * q4] += p4.x * vv[u]; o[4 * q4 + 1] += p4.y * vv[u]; o[4 * q4 + 2] += p4.z * vv[u]; o[4 * q4 + 3] += p4.w * vv[u]; } } }
        }
#pragma unroll
        for (int q = 0; q < 16; ++q) { comb[(C.wave * 16 + q) * 64 + lane] = o[q]; if (lane == 0) { ml[C.wave * 32 + q] = m[q]; ml[C.wave * 32 + 16 + q] = l[q]; } }
        __syncthreads();
        for (int i = C.tid; i < 1024; i += NT_) { const int q = i >> 6, d = i & 63; float mm = -1e30f;
#pragma unroll
            for (int w = 0; w < 8; ++w) mm = fmaxf(mm, ml[w * 32 + q]);
            float ll = 0.f, oo = 0.f;
#pragma unroll
            for (int w = 0; w < 8; ++w) { const float f = __builtin_amdgcn_exp2f(ml[w * 32 + q] - mm); ll += ml[w * 32 + 16 + q] * f; oo += comb[(w * 16 + q) * 64 + d] * f; }
            Qb[(size_t)(MP + 16 * b + q) * DM + 64 * h + d] = (bf16_t)f2bf(oo * __builtin_amdgcn_rcpf(ll)); }
        __syncthreads();
    }
}

__device__ __forceinline__ void small_gemm_res(const Ctx& C, const bf16_t* A, const bf16_t* Bt, int K, float* hf, bf16_t* hb, float* ssq, const float* xs) {
    const int lane = C.lane, li = lane & 15, gq = lane >> 4; const int kw = K / 8, nst = kw / 32;
    LAS float* part = (LAS float*)C.lds;
    for (int id = C.bid; id < 256; id += C.G) {
        const int rg = id >> 4, ct = id & 15, row0 = MP + 32 * rg, col0 = 64 * ct;
        const bf16_t* ap = A + (size_t)(row0 + li) * K + C.wave * kw + 8 * gq; const bf16_t* bp = Bt + (size_t)(col0 + li) * K + C.wave * kw + 8 * gq;
        f32x4 acc[2][4];
#pragma unroll
        for (int r2 = 0; r2 < 2; ++r2)
#pragma unroll
            for (int c = 0; c < 4; ++c) acc[r2][c] = (f32x4){0.f, 0.f, 0.f, 0.f};
        for (int s0 = 0; s0 < nst; s0 += 4) { bf16x8 a[4][2], b[4][4];
#pragma unroll
            for (int u = 0; u < 4; ++u) { const int s = min(s0 + u, nst - 1); a[u][0] = *(const bf16x8*)(ap + 32 * s); a[u][1] = *(const bf16x8*)(ap + (size_t)16 * K + 32 * s);
#pragma unroll
                for (int c = 0; c < 4; ++c) b[u][c] = *(const bf16x8*)(bp + (size_t)(16 * c) * K + 32 * s); }
#pragma unroll
            for (int u = 0; u < 4; ++u) if (s0 + u < nst) {
#pragma unroll
                for (int r2 = 0; r2 < 2; ++r2)
#pragma unroll
                    for (int c = 0; c < 4; ++c) acc[r2][c] = __builtin_amdgcn_mfma_f32_16x16x32_bf16(a[u][r2], b[u][c], acc[r2][c], 0, 0, 0); } }
#pragma unroll
        for (int r2 = 0; r2 < 2; ++r2)
#pragma unroll
            for (int c = 0; c < 4; ++c)
#pragma unroll
                for (int r = 0; r < 4; ++r) part[(C.wave * 32 + 16 * r2 + 4 * gq + r) * 64 + 16 * c + li] = acc[r2][c][r];
        __syncthreads();
        { int t2_ = C.tid; asm volatile("" : "+v"(t2_)); const int row = t2_ >> 4, cp = (t2_ & 15) * 4; f32x4 v = {0.f, 0.f, 0.f, 0.f};
#pragma unroll
            for (int w = 0; w < 8; ++w) v += *(const LAS f32x4*)(part + (w * 32 + row) * 64 + cp);
            const size_t idx = (size_t)(row0 + row) * DM + col0 + cp;
            if (xs) v += *(const f32x4*)(xs + idx - (size_t)MP * DM); else { const u32x2 hw = *(const u32x2*)(hb + idx); v += (f32x4){bflo(hw.x), bfhi(hw.x), bflo(hw.y), bfhi(hw.y)}; }
            *(u32x2*)(hb + idx) = (u32x2){pk2(v.x, v.y), pk2(v.z, v.w)};
            float sq = (v.x * v.x + v.y * v.y) + (v.z * v.z + v.w * v.w); sq += __shfl_xor(sq, 1); sq += __shfl_xor(sq, 2); sq += __shfl_xor(sq, 4); sq += __shfl_xor(sq, 8);
            if ((t2_ & 15) == 0) atomicAdd(ssq + row0 + row, sq); }
        __syncthreads();
    }
}

__device__ __forceinline__ void phase_norms(const Ctx& C) {
    const bf16_t* Qb = (const bf16_t*)(C.ws + WS_QB); const bf16_t* Kb = (const bf16_t*)(C.ws + WS_KB); float* nrm = (float*)(C.ws + WS_NRM);
    const int gw = C.bid * NW_ + C.wave, NGW = C.G * NW_;
    for (int task = gw; task < (MP / 64) * NH; task += NGW) { const int tile = task >> 4, h = task & 15; const unsigned off = (unsigned)((tile * 64 + C.lane) * DM + h * 64); float sq = 0.f, sk = 0.f;
#pragma unroll
        for (int c = 0; c < 8; ++c) { float f[8]; unpack8(*(const u32x4*)(Qb + off + 8 * c), f);
#pragma unroll
            for (int e = 0; e < 8; ++e) sq += f[e] * f[e];
            unpack8(*(const u32x4*)(Kb + off + 8 * c), f);
#pragma unroll
            for (int e = 0; e < 8; ++e) sk += f[e] * f[e]; }
        sq = wave_max(sq); sk = wave_max(sk);
        if (C.lane == 0) { nrm[h * 256 + tile] = sqrtf(sq) * 1.001f; nrm[NH * 256 + h * 256 + tile] = sqrtf(sk) * 1.001f; } }
}
struct NoBetween { __device__ __forceinline__ void operator()(int) const {} };
__global__ void __launch_bounds__(NT_, 2) mega_fwd(Args a) {
    __builtin_assume(__builtin_amdgcn_workitem_id_y() == 0); __builtin_assume(__builtin_amdgcn_workitem_id_z() == 0);
    extern __shared__ __attribute__((aligned(16))) unsigned char lds[];
    cg::grid_group grid = cg::this_grid();
    Ctx C; C.lds = (LAS unsigned char*)lds; C.tid = threadIdx.x; C.lane = C.tid & 63; C.wave = __builtin_amdgcn_readfirstlane(C.tid >> 6); C.G = gridDim.x; C.bid = blockIdx.x;
    { const float* const* inp = (const float* const*)__builtin_amdgcn_kernarg_segment_ptr(); asm volatile("" : "+s"(inp)); C.in = inp; }     C.out = a.out; C.ws = a.ws;
    unsigned char* ws = a.ws;
    float* ssq = (float*)(ws + WS_SSQ); constexpr size_t SSQN = (size_t)M;
    bf16_t* hb = (bf16_t*)(ws + WS_HB);
    const int lo = a.ph_lo, hi = a.ph_hi;
    unsigned* barw = (unsigned*)(ws + WS_BAR);
    if (C.tid < 2) ((volatile LAS unsigned*)(C.lds + LDS_TOTAL - 512))[C.tid] = 0u;
    if (C.bid == 0) for (int i = C.tid; i < XCD_BAR_WORDS; i += NT_) barw[i] = 0u;
    XcdBarrier bar; bar.bar = barw; bar.x = 0; bar.st = nullptr;
#ifndef GEMM_ALIGN
#define GEMM_ALIGN true
#endif
#ifndef ATTN_THRL
#define ATTN_THRL 40
#endif
#ifndef REP_MASK
#define REP_MASK 0
#endif
#ifndef EXTRA_SYNCS
#define EXTRA_SYNCS 0
#endif
#define IN(k) (lo <= (k) && (k) < hi)
#define SEAM(k) do { if (IN(k) && IN((k) + 1)) { if ((k) == 0) { grid.sync(); bar = xcd_barrier_post(barw, (volatile LAS unsigned*)(C.lds + LDS_TOTAL - 512)); } else xcd_barrier(bar); } } while (0)
#define GEMMM(EPI, E, Aop, Bop, M_, N_, K_) do { pg8::Gemm g_{(const bf16_t*)(Aop), (const bf16_t*)(Bop), (M_), (N_), (K_)}; pg8::StaticOrder S_; S_.init((M_), (N_), C.G, C.bid); \
        pg8::gemm_phase<EPI, pg8::StaticOrder, GEMM_ALIGN, true>(C.lds, g_, S_, E); __syncthreads(); } while (0)

#define GEMM(EPI, E, Aop, Bop, N_, K_) GEMMM(EPI, E, Aop, Bop, M, N_, K_)
#define GEMMS(EPI, E, Aop, Bop, N_, K_) do { pg8::Gemm g_{(const bf16_t*)(Aop), (const bf16_t*)(Bop), MS, (N_), (K_)}; pg8::StaticOrder S_; S_.init(MS, (N_), C.G, C.G - 1 - C.bid); \
        pg8::gemm_phase<EPI, pg8::StaticOrder, GEMM_ALIGN, true>(C.lds, g_, S_, E); __syncthreads(); } while (0)
#define GEMMR(E, Aop, Bop, K_) do { { pg8::Gemm g_{(const bf16_t*)(Aop), (const bf16_t*)(Bop), MP, DM, (K_)}; pg8::StaticOrder S_; S_.init(MP, DM, C.G, C.bid); \
        pg8::gemm_phase<EpiRes, pg8::StaticOrder, false, true>(C.lds, g_, S_, E); __syncthreads(); }     \
 small_gemm_res(C, (const bf16_t*)(Aop), (const bf16_t*)(Bop), (K_), E.hf, E.hb, E.ssq, E.xin ? a.in[1] : nullptr); } while (0)
    if (IN(0)) { phase_prologue(C); if (((REP_MASK >> 0) & 1)) { grid.sync(); phase_prologue(C); } }
    SEAM(0);
    if (IN(1)) { { EpiIn E{ssq, (bf16_t*)(ws + WS_ZB), (bf16_t*)(ws + WS_X1), (float*)(ws + WS_DT)}; GEMM(EpiIn, E, hb, ws + WS_WIN, NIN_PAD, DM); { int vi_, vn_; idle_vgrid(C, (M / 256) * (NIN_PAD / 256), vi_, vn_); convert_items(C, vi_, vn_, IT_UP0, IT_UP1); convert_items(C, vi_, vn_, IT_DN0, IT_DN1); } } if (((REP_MASK >> 1) & 1)) { grid.sync(); { EpiIn E{ssq, (bf16_t*)(ws + WS_ZB), (bf16_t*)(ws + WS_X1), (float*)(ws + WS_DT)}; GEMM(EpiIn, E, hb, ws + WS_WIN, NIN_PAD, DM); { int vi_, vn_; idle_vgrid(C, (M / 256) * (NIN_PAD / 256), vi_, vn_); convert_items(C, vi_, vn_, IT_UP0, IT_UP1); convert_items(C, vi_, vn_, IT_DN0, IT_DN1); } } } }
    SEAM(1);
    for (int i_ = 0; i_ < EXTRA_SYNCS; ++i_) xcd_barrier(bar);
    if (IN(2)) { phase_mconv(C); if (((REP_MASK >> 2) & 1)) { grid.sync(); phase_mconv(C); } }
    SEAM(2);
    if (IN(3)) { phase_ssd1(C, 0, NCH * 4); if (((REP_MASK >> 3) & 1)) { grid.sync(); phase_ssd1(C, 0, NCH * 4); } }
    SEAM(3);
    if (IN(4)) { phase_ssd1(C, NCH * 4, SSD_UNITS); phase_ssd3(C, NCH * 4, SSD_UNITS, C.G - (NSB * 4) % C.G); phase_scan(C); if (((REP_MASK >> 4) & 1)) { grid.sync(); phase_ssd1(C, NCH * 4, SSD_UNITS); phase_ssd3(C, NCH * 4, SSD_UNITS, C.G - (NSB * 4) % C.G); phase_scan(C); } }
    SEAM(4);
    if (IN(5)) { phase_ssd3(C, 0, NCH * 4, 0); if (((REP_MASK >> 5) & 1)) { grid.sync(); phase_ssd3(C, 0, NCH * 4, 0); } }
    SEAM(5);
    if (IN(6)) { { EpiRes E{a.out, hb, ssq + SSQN, a.in[0]}; GEMMR(E, ws + WS_X1, ws + WS_WOUT, DI); } if (((REP_MASK >> 6) & 1)) { grid.sync(); { EpiRes E{a.out, hb, ssq + SSQN, a.in[0]}; GEMMR(E, ws + WS_X1, ws + WS_WOUT, DI); } } }
    SEAM(6);
    if (IN(7)) { { EpiUp E2{ssq + SSQN + MP, (bf16_t*)(ws + WS_UPS)}; GEMMS(EpiUp, E2, hb + (size_t)MP * DM, ws + WS_WUP, NUP, DM); EpiUpF E{ssq + SSQN, (bf16_t*)(ws + WS_G), (float*)(ws + WS_EDGE), a.in[26], a.in[27]}; GEMMM(EpiUpF, E, hb, ws + WS_WUP, MP, NUP, DM); { const int ex_ = ((MP / 256) * (NUP / 256)) % C.G, sm_ = (MS / 256) * (NUP / 256); const int hi_ = C.G - sm_; const bool idle_ = ex_ > 0 && hi_ > ex_ && C.bid >= ex_ && C.bid < hi_; convert_items(C, idle_ ? C.bid - ex_ : (ex_ > 0 && hi_ > ex_ ? -1 : C.bid), ex_ > 0 && hi_ > ex_ ? hi_ - ex_ : C.G, IT_Q, IT_O); } } if (((REP_MASK >> 7) & 1)) { grid.sync(); { EpiUp E2{ssq + SSQN + MP, (bf16_t*)(ws + WS_UPS)}; GEMMS(EpiUp, E2, hb + (size_t)MP * DM, ws + WS_WUP, NUP, DM); EpiUpF E{ssq + SSQN, (bf16_t*)(ws + WS_G), (float*)(ws + WS_EDGE), a.in[26], a.in[27]}; GEMMM(EpiUpF, E, hb, ws + WS_WUP, MP, NUP, DM); { const int ex_ = ((MP / 256) * (NUP / 256)) % C.G, sm_ = (MS / 256) * (NUP / 256); const int hi_ = C.G - sm_; const bool idle_ = ex_ > 0 && hi_ > ex_ && C.bid >= ex_ && C.bid < hi_; convert_items(C, idle_ ? C.bid - ex_ : (ex_ > 0 && hi_ > ex_ ? -1 : C.bid), ex_ > 0 && hi_ > ex_ ? hi_ - ex_ : C.G, IT_Q, IT_O); } } } }
    SEAM(7);
    if (IN(8)) { phase_fconv(C, 0); if (((REP_MASK >> 8) & 1)) { grid.sync(); phase_fconv(C, 0); } }
    SEAM(8);
    if (IN(9)) { { EpiRes E{a.out, hb, ssq + 2 * SSQN, nullptr}; GEMMR(E, ws + WS_G, ws + WS_WDN, DFF); } if (((REP_MASK >> 9) & 1)) { grid.sync(); { EpiRes E{a.out, hb, ssq + 2 * SSQN, nullptr}; GEMMR(E, ws + WS_G, ws + WS_WDN, DFF); } } }
    SEAM(9);
    if (IN(10)) { { EpiQkv E{ssq + 2 * SSQN, (bf16_t*)(ws + WS_QB), (bf16_t*)(ws + WS_KB), (bf16_t*)(ws + WS_VB), a.out, C.in[22]}; GEMM(EpiQkv, E, hb, ws + WS_WQ, NQ, DM); { int vi_, vn_; idle_vgrid(C, (M / 256) * (NQ / 256), vi_, vn_); convert_items(C, vi_, vn_, IT_UP1, IT_DN0); convert_items(C, vi_, vn_, IT_DN1, IT_Q); convert_items(C, vi_, vn_, IT_O, IT_END); } } if (((REP_MASK >> 10) & 1)) { grid.sync(); { EpiQkv E{ssq + 2 * SSQN, (bf16_t*)(ws + WS_QB), (bf16_t*)(ws + WS_KB), (bf16_t*)(ws + WS_VB), a.out, C.in[22]}; GEMM(EpiQkv, E, hb, ws + WS_WQ, NQ, DM); { int vi_, vn_; idle_vgrid(C, (M / 256) * (NQ / 256), vi_, vn_); convert_items(C, vi_, vn_, IT_UP1, IT_DN0); convert_items(C, vi_, vn_, IT_DN1, IT_Q); convert_items(C, vi_, vn_, IT_O, IT_END); } } } }
    SEAM(10);
    if (IN(11)) { phase_cumsum(C); phase_norms(C); if (((REP_MASK >> 11) & 1)) { grid.sync(); phase_cumsum(C); phase_norms(C); } }
    SEAM(11);
    if (IN(12)) {
        const attn_body::AttnTensors AT{(const attn_body::bf16*)(ws + WS_QB), (const attn_body::bf16*)(ws + WS_KB), (const attn_body::bf16*)(ws + WS_VB), (attn_body::bf16*)(ws + WS_QB)};
        const attn_body::StaticOrder S((int)C.G, (int)C.bid);
        attn_body::attn_phase<attn_body::StaticOrder, ATTN_THRL>((char*)lds, AT, S, (const float*)(ws + WS_CB), (const float*)(ws + WS_NRM));
        __syncthreads();
#ifdef REP_ATTN
        { grid.sync(); const attn_body::AttnTensors AT2{(const attn_body::bf16*)(ws + WS_QB), (const attn_body::bf16*)(ws + WS_KB), (const attn_body::bf16*)(ws + WS_VB), (attn_body::bf16*)(ws + WS_G)};
          for (int rep_ = 0; rep_ < REP_ATTN; ++rep_) { attn_body::attn_phase<attn_body::StaticOrder, ATTN_THRL>((char*)lds, AT2, S, (const float*)(ws + WS_CB), (const float*)(ws + WS_NRM)); __syncthreads(); } }
#endif
        phase_attn_sample(C);
    }
    SEAM(12);
    if (IN(13)) { { EpiRes E{a.out, hb, ssq + 3 * SSQN, nullptr}; GEMMR(E, ws + WS_QB, ws + WS_WO, DM); } if (((REP_MASK >> 13) & 1)) { grid.sync(); { EpiRes E{a.out, hb, ssq + 3 * SSQN, nullptr}; GEMMR(E, ws + WS_QB, ws + WS_WO, DM); } } }
    SEAM(13);
    if (IN(14)) { { EpiUp E2{ssq + 3 * SSQN + MP, (bf16_t*)(ws + WS_UPS)}; GEMMS(EpiUp, E2, hb + (size_t)MP * DM, ws + WS_WUP + (size_t)NUP * DM * 2, NUP, DM); EpiUpF E{ssq + 3 * SSQN, (bf16_t*)(ws + WS_G), (float*)(ws + WS_EDGE), a.in[26] + 3 * NUP, a.in[27] + NUP}; GEMMM(EpiUpF, E, hb, ws + WS_WUP + (size_t)NUP * DM * 2, MP, NUP, DM); } if (((REP_MASK >> 14) & 1)) { grid.sync(); { EpiUp E2{ssq + 3 * SSQN + MP, (bf16_t*)(ws + WS_UPS)}; GEMMS(EpiUp, E2, hb + (size_t)MP * DM, ws + WS_WUP + (size_t)NUP * DM * 2, NUP, DM); EpiUpF E{ssq + 3 * SSQN, (bf16_t*)(ws + WS_G), (float*)(ws + WS_EDGE), a.in[26] + 3 * NUP, a.in[27] + NUP}; GEMMM(EpiUpF, E, hb, ws + WS_WUP + (size_t)NUP * DM * 2, MP, NUP, DM); } } }
    SEAM(14);
    if (IN(15)) { phase_fconv(C, 1); if (((REP_MASK >> 15) & 1)) { grid.sync(); phase_fconv(C, 1); } }
    SEAM(15);
    if (IN(16)) { { EpiRes E{a.out, hb, ssq, nullptr}; GEMMR(E, ws + WS_G, ws + WS_WDN + (size_t)DM * DFF * 2, DFF); } if (((REP_MASK >> 16) & 1)) { grid.sync(); { EpiRes E{a.out, hb, ssq, nullptr}; GEMMR(E, ws + WS_G, ws + WS_WDN + (size_t)DM * DFF * 2, DFF); } } }
    SEAM(16);
    if (IN(17)) { phase_final(C); if (((REP_MASK >> 17) & 1)) { grid.sync(); phase_final(C); } }
#undef IN
#undef SEAM
#undef GEMM
#undef GEMMM
#undef GEMMR
#undef GEMMS
}
constexpr int N_PHASES = 18;
#ifndef MK_SPLIT
#define MK_SPLIT 0
#endif
extern "C" void kernel_launch(void* const* d_in, const int* in_sizes, int n_in, void* d_out, int out_size, void* d_ws, size_t ws_size, hipStream_t stream) {
    static int grid = 0;
    if (grid == 0) {
        if (n_in != 30 || (size_t)out_size != O_END || ws_size < WS_NEED) { fprintf(stderr, "kernel_launch: unexpected sizes n_in %d out %d (want %zu) ws %zu (need %zu)\n", n_in, out_size, (size_t)O_END, ws_size, (size_t)WS_NEED); grid = -1; return; }
        int dev = 0, cus = 0, per_cu = 0;
        hipGetDevice(&dev); hipDeviceGetAttribute(&cus, hipDeviceAttributeMultiprocessorCount, dev);
        hipFuncSetAttribute((const void*)mega_fwd, hipFuncAttributeMaxDynamicSharedMemorySize, LDS_TOTAL);
        hipOccupancyMaxActiveBlocksPerMultiprocessor(&per_cu, (const void*)mega_fwd, NT_, LDS_TOTAL);
        if (per_cu < 1) { fprintf(stderr, "kernel_launch: occupancy query says %d blocks per CU\n", per_cu); per_cu = 1; }
        (void)hipGetLastError();
        grid = cus * 1;
    }
    if (grid < 0) return;
    Args a{};
    for (int i = 0; i < 30; ++i) a.in[i] = (const float*)d_in[i];
    a.out = (float*)d_out; a.ws = (unsigned char*)d_ws;
#if MK_SPLIT
    for (int p = 0; p < N_PHASES; ++p) { a.ph_lo = p; a.ph_hi = p + 1; hipLaunchKernelGGL(mega_fwd, dim3(grid), dim3(NT_), LDS_TOTAL, stream, a); }
#else
    a.ph_lo = 0; a.ph_hi = N_PHASES;
    void* args[] = {&a};
    hipError_t e = hipLaunchCooperativeKernel((const void*)mega_fwd, dim3(grid), dim3(NT_), args, LDS_TOTAL, stream);
    if (e != hipSuccess) fprintf(stderr, "cooperative launch failed: %s (grid %d)\n", hipGetErrorString(e), grid);
#endif
}
```

```cpp
#include <hip/hip_runtime.h>
#include <hip/hip_cooperative_groups.h>
#include <cstdio>
#include <cstdint>
namespace cg = cooperative_groups;

namespace pg8 {
#define PG8_LAS __attribute__((address_space(3)))
typedef unsigned short bf16_t;
typedef short bf16x8 __attribute__((ext_vector_type(8)));
typedef float f32x4 __attribute__((ext_vector_type(4)));
typedef unsigned u32x4 __attribute__((ext_vector_type(4)));
constexpr int BM = 256, BK = 64, HALF = 128, HTB = HALF * BK * 2  , STAGE_BYTES = 8 * HTB, NXCD = 8, WGM = 8;

__host__ __device__ __forceinline__ int lds_byte(int r, int c) { const int st = (r >> 4) * 2 + (c >> 5), rr = r & 15, cc = c & 31, ob = rr * 64 + cc * 2; return st * 1024 + (ob ^ (((ob >> 9) & 1) << 5)); }
__host__ __device__ __forceinline__ void stage_rc(int b, int& R, int& C) { const int st = b / 1024, sb = b % 1024, swz = sb ^ (((sb >> 9) & 1) << 5); R = (st >> 1) * 16 + swz / 64; C = (st & 1) * 32 + (swz % 64) / 2; }
__host__ __device__ __forceinline__ int perm32(int rho) { const int n = rho >> 4, i = rho & 15; return 8 * (i >> 2) + 4 * n + (i & 3); }

struct Unit { int pm, pn; };
struct Gemm { const bf16_t* A; const bf16_t* Bt; int M, N, K; };

struct StaticOrder {
    int nM, nN, nwg, G, c;
    __host__ __device__ void init(int M, int N, int G_, int c_) { nM = M / BM; nN = N / BM; nwg = nM * nN; G = G_; c = c_; }
    __host__ __device__ bool next(int i, Unit& u) const {
        const long L = (long)i * G + c; if (L >= nwg) return false;
        int wgid = (int)L; { const int q = nwg / NXCD, r = nwg % NXCD, xcd = wgid % NXCD, off = wgid / NXCD; wgid = (xcd < r ? xcd * (q + 1) : r * (q + 1) + (xcd - r) * q) + off; }
        const int nig = WGM * nN, gid = wgid / nig, fm = gid * WGM, gsz = (nM - fm) < WGM ? (nM - fm) : WGM;
        u.pm = fm + ((wgid % nig) % gsz); u.pn = (wgid % nig) / gsz; return true;
    }
    __device__ __forceinline__ void a_ready(const Unit&) const {}
    __device__ __forceinline__ void done(const Unit&) const {}
};

__device__ __forceinline__ unsigned cvt_pk_bf16(float lo, float hi) { unsigned r; asm volatile("v_cvt_pk_bf16_f32 %0, %1, %2" : "=v"(r) : "v"(lo), "v"(hi)); return r; }
typedef float f32x2 __attribute__((ext_vector_type(2)));
__device__ __forceinline__ f32x2 gelu_pk(f32x2 v) {
    const f32x2 av = __builtin_elementwise_abs(v), d = av * 0.2316418882f + 1.0f;
    f32x2 t; t.x = __builtin_amdgcn_rcpf(d.x); t.y = __builtin_amdgcn_rcpf(d.y);
    f32x2 q = t * 0.5307027145f + (-0.7265760135f); q = q * t + 0.7107068705f; q = q * t + (-0.142248368f); q = q * t + 0.127414796f; q = q * t;
    const f32x2 s = (v * v) * (-0.72134752044f);
    f32x2 e; e.x = __builtin_amdgcn_exp2f(s.x); e.y = __builtin_amdgcn_exp2f(s.y);
    const f32x2 m = v * (q * e), r = v - m;
    f32x2 o; o.x = v.x < 0.f ? m.x : r.x; o.y = v.y < 0.f ? m.y : r.y; return o;
}

template <int ACT  > struct EpiBf16 {
    static constexpr bool PERM = true, AFTER_DRAIN = false; static_assert(ACT == 0 || ACT == 1, "EpiBf16: ACT is 0 (none) or 1 (gelu_pk)");
    bf16_t* O; int ldc; const float* bias; int split_cols; size_t split_stride; float scale0;
    __device__ __forceinline__ void operator()(const f32x4 (&acc)[2][2][4][2], const Unit& u, int wr, int wc, int fr, int fq) const {
        const int row0 = u.pm * BM + wr * 64 + fr; int colt = u.pn * BM; bf16_t* base = O;
        float sc = 1.f; if (split_cols) { const int t = colt / split_cols; base += (size_t)t * split_stride; colt -= t * split_cols; if (t == 0) sc = scale0; }
        const int col0 = colt + wc * 32 + 8 * fq, bcol0 = u.pn * BM + wc * 32 + 8 * fq;
        f32x4 bv[2][2];
#pragma unroll
        for (int bj = 0; bj < 2; ++bj)
#pragma unroll
            for (int n = 0; n < 2; ++n) bv[bj][n] = bias ? *(const f32x4*)(bias + bcol0 + bj * HALF + 4 * n) : (f32x4){0.f, 0.f, 0.f, 0.f};
#pragma unroll
        for (int ai = 0; ai < 2; ++ai)
#pragma unroll
            for (int m = 0; m < 4; ++m) { bf16_t* rowp = base + (size_t)(row0 + ai * HALF + m * 16) * ldc + col0;
#pragma unroll
                for (int bj = 0; bj < 2; ++bj) { f32x4 v0 = acc[ai][bj][m][0] + bv[bj][0], v1 = acc[ai][bj][m][1] + bv[bj][1];
                    if (ACT == 1) { f32x2 a = gelu_pk((f32x2){v0[0], v0[1]}), b = gelu_pk((f32x2){v0[2], v0[3]}), c = gelu_pk((f32x2){v1[0], v1[1]}), d = gelu_pk((f32x2){v1[2], v1[3]});
                        v0 = (f32x4){a.x, a.y, b.x, b.y}; v1 = (f32x4){c.x, c.y, d.x, d.y}; }
                    v0 = v0 * sc; v1 = v1 * sc; u32x4 w; w.x = cvt_pk_bf16(v0[0], v0[1]); w.y = cvt_pk_bf16(v0[2], v0[3]); w.z = cvt_pk_bf16(v1[0], v1[1]); w.w = cvt_pk_bf16(v1[2], v1[3]);
                    *(u32x4*)(rowp + bj * HALF) = w; } }
    }
};

struct PanelStats {
    unsigned* xbuf;
    unsigned* cnt;
    unsigned* tmo;
    int ntn; float eps;
    unsigned code;
    __device__ __forceinline__ bool run(const f32x4 (&v)[2][2][4][2], const Unit& u, int wr, int wc, int fr, int fq, PG8_LAS unsigned char* lds, int wid, int lane) const {
        typedef float f32x2v __attribute__((ext_vector_type(2)));
        PG8_LAS f32x2v* P = (PG8_LAS f32x2v*)lds;
        PG8_LAS f32x2v* S = (PG8_LAS f32x2v*)(lds + 8192);
        PG8_LAS unsigned* flag = (PG8_LAS unsigned*)(lds + 8192 + 2048);
#pragma unroll
        for (int ai = 0; ai < 2; ++ai)
#pragma unroll
            for (int m = 0; m < 4; ++m) {
                float s = 0.f;
#pragma unroll
                for (int bj = 0; bj < 2; ++bj)
#pragma unroll
                    for (int n = 0; n < 2; ++n) { const f32x4 x = v[ai][bj][m][n]; s += (x[0] + x[1]) + (x[2] + x[3]); }
                s += __shfl_xor(s, 16); s += __shfl_xor(s, 32);
                const float mw = s * (1.0f / 64.0f); float q = 0.f;
#pragma unroll
                for (int bj = 0; bj < 2; ++bj)
#pragma unroll
                    for (int n = 0; n < 2; ++n) { const f32x4 d = v[ai][bj][m][n] - mw; q += (d[0] * d[0] + d[1] * d[1]) + (d[2] * d[2] + d[3] * d[3]); }
                q += __shfl_xor(q, 16); q += __shfl_xor(q, 32);
                if (fq == 0) P[(ai * HALF + wr * 64 + m * 16 + fr) * 4 + wc] = (f32x2v){mw, q};
            }
        asm volatile("s_waitcnt lgkmcnt(0)" ::: "memory"); __builtin_amdgcn_s_barrier(); asm volatile("" ::: "memory");
#if defined(BROKEN_EXCHANGE_NO_WAIT)
#warning BROKEN CONTROL BUILD: the row-statistics exchange does not wait; results are wrong by design
        if (blockIdx.x >= 64) { const long long t0_ = clock64(); while (clock64() - t0_ < 60000) __builtin_amdgcn_s_sleep(8); }
#endif
        const int row = wid * 32 + (lane & 31);
        if (lane < 32) {
            const f32x2v a = P[row * 4 + 0], b = P[row * 4 + 1], c = P[row * 4 + 2], d = P[row * 4 + 3];
            const float mt = (a.x + b.x + c.x + d.x) * 0.25f;
            const float da = a.x - mt, db = b.x - mt, dc = c.x - mt, dd = d.x - mt;
            const float m2 = (a.y + b.y) + (c.y + d.y) + 64.0f * ((da * da + db * db) + (dc * dc + dd * dd));
            unsigned long long* slot = (unsigned long long*)xbuf + ((size_t)(u.pm * BM + row) * 4 + u.pn);
            __hip_atomic_store(slot, ((unsigned long long)__float_as_uint(m2) << 32) | __float_as_uint(mt), __ATOMIC_RELAXED, __HIP_MEMORY_SCOPE_AGENT);
        }
        asm volatile("s_waitcnt vmcnt(0)" ::: "memory");
        if (lane == 0) __hip_atomic_fetch_add(cnt + 64 * u.pm, 1u, __ATOMIC_RELAXED, __HIP_MEMORY_SCOPE_AGENT);
        if (wid == 0) {
            bool dead = false; const unsigned long long t0 = __builtin_amdgcn_s_memrealtime(); const unsigned want = 8u * (unsigned)ntn;
            for (;;) {
#if defined(BROKEN_EXCHANGE_NO_WAIT)
                break;
#endif
                if ((unsigned)__builtin_amdgcn_readfirstlane(__hip_atomic_load(cnt + 64 * u.pm, __ATOMIC_RELAXED, __HIP_MEMORY_SCOPE_AGENT)) >= want) break;
                if (__builtin_amdgcn_s_memrealtime() - t0 > 2000000ull) {
                    if (lane == 0) { unsigned expect = 0u; __hip_atomic_compare_exchange_strong(tmo + 1, &expect, code | (unsigned)(u.pm & 0xff), __ATOMIC_RELAXED, __ATOMIC_RELAXED, __HIP_MEMORY_SCOPE_AGENT);
                                     __hip_atomic_store(tmo, 1u, __ATOMIC_RELAXED, __HIP_MEMORY_SCOPE_AGENT); }
                    dead = true; break; }
                __builtin_amdgcn_s_sleep(2);
            }
            __builtin_amdgcn_fence(__ATOMIC_ACQUIRE, "agent");
            if (lane == 0) flag[0] = dead ? 1u : 0u;
        }
        asm volatile("s_waitcnt vmcnt(0) lgkmcnt(0)" ::: "memory"); __builtin_amdgcn_s_barrier(); asm volatile("" ::: "memory");
        const bool bad = flag[0] != 0u;
        if (lane < 32) {
            const unsigned long long* slot = (const unsigned long long*)xbuf + (size_t)(u.pm * BM + row) * 4; float mt[4], m2[4]; float ms = 0.f;
#pragma unroll
            for (int t = 0; t < 4; ++t) { if (t < ntn) { const unsigned long long w = __hip_atomic_load(slot + t, __ATOMIC_RELAXED, __HIP_MEMORY_SCOPE_AGENT); mt[t] = __uint_as_float((unsigned)w); m2[t] = __uint_as_float((unsigned)(w >> 32)); } else { mt[t] = 0.f; m2[t] = 0.f; } ms += mt[t]; }
            const float mean = ms / (float)ntn; float q = 0.f;
#pragma unroll
            for (int t = 0; t < 4; ++t) if (t < ntn) { const float dm = mt[t] - mean; q += m2[t] + 256.0f * dm * dm; }
            S[row] = (f32x2v){mean, 1.0f / sqrtf(q / (256.0f * (float)ntn) + eps)};
        }
        asm volatile("s_waitcnt lgkmcnt(0)" ::: "memory"); __builtin_amdgcn_s_barrier(); asm volatile("" ::: "memory");
        return bad;
    }
};
struct EpiLnRes {
    static constexpr bool PERM = false, AFTER_DRAIN = true;
    const float* base; float* out; int ldc; const float* bias; PanelStats st; unsigned poison;
    __device__ __forceinline__ void fused(f32x4 (&acc)[2][2][4][2], const Unit& u, int wr, int wc, int fr, int fq, PG8_LAS unsigned char* lds, int wid, int lane) const {
        typedef float f32x2v __attribute__((ext_vector_type(2)));
        const PG8_LAS f32x2v* S = (const PG8_LAS f32x2v*)(lds + 8192);
        const int col0 = u.pn * BM + wc * 32 + 4 * fq;
#pragma unroll
        for (int bj = 0; bj < 2; ++bj)
#pragma unroll
            for (int n = 0; n < 2; ++n) { const f32x4 bv = bias ? *(const f32x4*)(bias + col0 + bj * HALF + n * 16) : (f32x4){0.f, 0.f, 0.f, 0.f};
#pragma unroll
                for (int ai = 0; ai < 2; ++ai)
#pragma unroll
                    for (int m = 0; m < 4; ++m) acc[ai][bj][m][n] += bv; }
        f32x4 pre[4][2][2];
#pragma unroll
        for (int m = 0; m < 4; ++m) { const size_t off = (size_t)(u.pm * BM + wr * 64 + m * 16 + fr) * ldc + col0;
#pragma unroll
            for (int bj = 0; bj < 2; ++bj)
#pragma unroll
                for (int n = 0; n < 2; ++n) pre[m][bj][n] = *(const f32x4*)(base + off + bj * HALF + n * 16); }
        const bool bad = st.run(acc, u, wr, wc, fr, fq, lds, wid, lane) || poison != 0u;
        const float qnan = __builtin_nanf("");
#pragma unroll
        for (int ai = 0; ai < 2; ++ai)
#pragma unroll
            for (int m = 0; m < 4; ++m) { const int r = ai * HALF + wr * 64 + m * 16 + fr; const f32x2v sr = S[r]; const size_t off = (size_t)(u.pm * BM + r) * ldc + col0;
#pragma unroll
                for (int bj = 0; bj < 2; ++bj)
#pragma unroll
                    for (int n = 0; n < 2; ++n) { const f32x4 bs = ai == 0 ? pre[m][bj][n] : *(const f32x4*)(base + off + bj * HALF + n * 16); f32x4 o = bs + (acc[ai][bj][m][n] - sr.x) * sr.y;
                        if (bad) o = (f32x4){qnan, qnan, qnan, qnan}; *(f32x4*)(out + off + bj * HALF + n * 16) = o; }
                if (m & 1) asm volatile("" ::: "memory"); }
    }
};
struct EpiLnResLn {
    static constexpr bool PERM = false, AFTER_DRAIN = true;
    const float* base; float* out; bf16_t* xn; int ldc; const float* bias; PanelStats st1, st2; unsigned poison;
    __device__ __forceinline__ void fused(f32x4 (&acc)[2][2][4][2], const Unit& u, int wr, int wc, int fr, int fq, PG8_LAS unsigned char* lds, int wid, int lane) const {
        typedef float f32x2v __attribute__((ext_vector_type(2))); typedef unsigned u32x2v __attribute__((ext_vector_type(2)));
        const PG8_LAS f32x2v* S = (const PG8_LAS f32x2v*)(lds + 8192);
        const int col0 = u.pn * BM + wc * 32 + 4 * fq;
#pragma unroll
        for (int bj = 0; bj < 2; ++bj)
#pragma unroll
            for (int n = 0; n < 2; ++n) { const f32x4 bv = bias ? *(const f32x4*)(bias + col0 + bj * HALF + n * 16) : (f32x4){0.f, 0.f, 0.f, 0.f};
#pragma unroll
                for (int ai = 0; ai < 2; ++ai)
#pragma unroll
                    for (int m = 0; m < 4; ++m) acc[ai][bj][m][n] += bv; }
        bool bad = st1.run(acc, u, wr, wc, fr, fq, lds, wid, lane) || poison != 0u;
        const float qnan = __builtin_nanf("");
#pragma unroll
        for (int ai = 0; ai < 2; ++ai)
#pragma unroll
            for (int m = 0; m < 4; ++m) { const int r = ai * HALF + wr * 64 + m * 16 + fr; const f32x2v sr = S[r]; const size_t off = (size_t)(u.pm * BM + r) * ldc + col0;
#pragma unroll
                for (int bj = 0; bj < 2; ++bj)
#pragma unroll
                    for (int n = 0; n < 2; ++n) { const f32x4 bs = *(const f32x4*)(base + off + bj * HALF + n * 16); acc[ai][bj][m][n] = bs + (acc[ai][bj][m][n] - sr.x) * sr.y; }
                asm volatile("" : "+v"(acc[ai][0][m][0]), "+v"(acc[ai][0][m][1]), "+v"(acc[ai][1][m][0]), "+v"(acc[ai][1][m][1]));
                if (m & 1) asm volatile("" ::: "memory"); }
        const bool bad1 = bad;
        bad = st2.run(acc, u, wr, wc, fr, fq, lds, wid, lane) || bad;
#pragma unroll
        for (int ai = 0; ai < 2; ++ai)
#pragma unroll
            for (int m = 0; m < 4; ++m) { const int r = ai * HALF + wr * 64 + m * 16 + fr; const f32x2v sr = S[r]; const size_t off = (size_t)(u.pm * BM + r) * ldc + col0;
#pragma unroll
                for (int bj = 0; bj < 2; ++bj)
#pragma unroll
                    for (int n = 0; n < 2; ++n) { const f32x4 x1 = acc[ai][bj][m][n]; *(f32x4*)(out + off + bj * HALF + n * 16) = bad1 ? (f32x4){qnan, qnan, qnan, qnan} : x1;
                        const f32x4 o = (x1 - sr.x) * sr.y; u32x2v w; w.x = cvt_pk_bf16(o[0], o[1]); w.y = cvt_pk_bf16(o[2], o[3]);
                        if (bad) { w.x = 0x7fc07fc0u; w.y = 0x7fc07fc0u; } *(u32x2v*)(xn + off + bj * HALF + n * 16) = w; }
                asm volatile("" ::: "memory"); }
    }
};

template <class Epi, class Sched, bool ALIGN_EPI = false, bool SP2 = false>
__device__ __forceinline__ void gemm_phase(PG8_LAS unsigned char* lds, const Gemm g, const Sched& S, const Epi& E) {
    const int tid = threadIdx.x, wid = __builtin_amdgcn_readfirstlane(tid >> 6), lane = tid & 63, wr = wid >> 2, wc = wid & 3, fr = lane & 15, fq = lane >> 4;
    const int K = g.K, nt = K / BK;
    unsigned voffA[2], voffB[2];
#pragma unroll
    for (int i = 0; i < 2; ++i) { int R, C; stage_rc(tid * 16 + i * 8192, R, C); const int Rb = Epi::PERM ? ((R & ~31) + perm32(R & 31)) : R;
        voffA[i] = (unsigned)(R * K + C) * 2u; voffB[i] = (unsigned)(Rb * K + C) * 2u; }
    const size_t kstep = (size_t)(BK * 2);
    const size_t hstep = (size_t)HALF * K * 2;
    const size_t tstep = 2 * hstep;
    const unsigned ldsw = (unsigned)wid * 1024u;
    const int aoff = lds_byte(wr * 64 + fr, fq * 8), boff = lds_byte(wc * 32 + fr, fq * 8);
#define PG8_SA(b, h) (((b) * 2 + (h)) * HTB)
#define PG8_SB(b, h) ((4 + (b) * 2 + (h)) * HTB)
#define PG8_STAGE(bufoff, gbase, voff) do { _Pragma("unroll") for (int _i = 0; _i < 2; ++_i) \
        __builtin_amdgcn_global_load_lds((const unsigned*)((const char*)(gbase) + (voff)[_i]), (PG8_LAS unsigned*)(lds + (bufoff) + ldsw + _i * 8192), 16, 0, 0); } while (0)
#define PG8_LDA(dst, b, h) do { _Pragma("unroll") for (int m = 0; m < 4; ++m) _Pragma("unroll") for (int k = 0; k < 2; ++k) dst[m][k] = *(const PG8_LAS bf16x8*)(lds + PG8_SA(b, h) + aoff + m * 2048 + k * 1024); } while (0)
#define PG8_LDB(dst, b, h) do { _Pragma("unroll") for (int n = 0; n < 2; ++n) _Pragma("unroll") for (int k = 0; k < 2; ++k) dst[n][k] = *(const PG8_LAS bf16x8*)(lds + PG8_SB(b, h) + boff + n * 2048 + k * 1024); } while (0)
#define PG8_MMA(ai, bj, At, Bt) do { __builtin_amdgcn_s_setprio(1); _Pragma("unroll") for (int m = 0; m < 4; ++m) _Pragma("unroll") for (int n = 0; n < 2; ++n) _Pragma("unroll") for (int k = 0; k < 2; ++k) \
        acc[ai][bj][m][n] = __builtin_amdgcn_mfma_f32_16x16x32_bf16(Bt[n][k], At[m][k], acc[ai][bj][m][n], 0, 0, 0); __builtin_amdgcn_s_setprio(0); } while (0)
#define PG8_WAIT_V(n) asm volatile("s_waitcnt vmcnt(" #n ")" ::: "memory")
#define PG8_WAIT_L(n) asm volatile("s_waitcnt lgkmcnt(" #n ")" ::: "memory")
#define PG8_BAR __builtin_amdgcn_s_barrier()
#define PG8_SCHED __builtin_amdgcn_sched_barrier(0)
    Unit cur, nxt; int ui = 0;
    if (!S.next(0, cur)) return;
    f32x4 acc[2][2][4][2];
#pragma unroll
    for (int a = 0; a < 2; ++a)
#pragma unroll
        for (int b = 0; b < 2; ++b)
#pragma unroll
            for (int m = 0; m < 4; ++m)
#pragma unroll
                for (int n = 0; n < 2; ++n) acc[a][b][m][n] = (f32x4){0.f, 0.f, 0.f, 0.f};
    bf16x8 At[4][2], B0[2][2], B1[2][2];
    const char* cA = (const char*)g.A + (size_t)cur.pm * tstep; const char* cB = (const char*)g.Bt + (size_t)cur.pn * tstep;
    S.a_ready(cur);
    if constexpr (SP2) {
        PG8_STAGE(PG8_SB(0, 0), cB, voffB); PG8_STAGE(PG8_SB(0, 1), cB + hstep, voffB); PG8_STAGE(PG8_SA(0, 0), cA, voffA); PG8_STAGE(PG8_SA(0, 1), cA + hstep, voffA);
        if (wr == 1) PG8_BAR;
        PG8_WAIT_V(2); PG8_BAR;
        PG8_STAGE(PG8_SB(1, 0), cB + kstep, voffB); PG8_STAGE(PG8_SA(1, 0), cA + kstep, voffA); PG8_STAGE(PG8_SB(1, 1), cB + hstep + kstep, voffB);
        PG8_WAIT_V(6); PG8_BAR;
    } else {
        PG8_STAGE(PG8_SB(0, 0), cB, voffB); PG8_STAGE(PG8_SA(0, 0), cA, voffA); PG8_STAGE(PG8_SB(0, 1), cB + hstep, voffB); PG8_STAGE(PG8_SA(0, 1), cA + hstep, voffA);
        if (wr == 1) PG8_BAR;
        PG8_WAIT_V(4); PG8_BAR;
        PG8_STAGE(PG8_SB(1, 0), cB + kstep, voffB); PG8_STAGE(PG8_SA(1, 0), cA + kstep, voffA); PG8_STAGE(PG8_SB(1, 1), cB + hstep + kstep, voffB);
        PG8_WAIT_V(6); PG8_BAR;
    }
    for (;;) {
        const bool has_next = S.next(ui + 1, nxt);
        const char* nA = has_next ? (const char*)g.A + (size_t)nxt.pm * tstep : cA; const char* nB = has_next ? (const char*)g.Bt + (size_t)nxt.pn * tstep : cB;
        for (int t = 0; t < nt; t += 2) {
            const bool last = (t == nt - 2);
            const char* a1 = cA + (size_t)(t + 1) * kstep;
            const char* a2 = last ? nA : cA + (size_t)(t + 2) * kstep; const char* b2 = last ? nB : cB + (size_t)(t + 2) * kstep;
            const char* a3 = a2 + kstep; const char* b3 = b2 + kstep;
            if (last && has_next) S.a_ready(nxt);
            if constexpr (SP2) {
            PG8_LDB(B0, 0, 0); PG8_LDB(B1, 0, 1); PG8_SCHED; PG8_LDA(At, 0, 0); PG8_STAGE(PG8_SA(1, 1), a1 + hstep, voffA);
            PG8_WAIT_V(8); PG8_WAIT_L(0); PG8_BAR; PG8_MMA(0, 0, At, B0); PG8_MMA(0, 1, At, B1); PG8_BAR; PG8_SCHED;
            PG8_LDA(At, 0, 1); PG8_STAGE(PG8_SB(0, 0), b2, voffB); PG8_STAGE(PG8_SB(0, 1), b2 + hstep, voffB); PG8_STAGE(PG8_SA(0, 0), a2, voffA);
            PG8_WAIT_V(8); PG8_WAIT_L(0); PG8_BAR; PG8_MMA(1, 0, At, B0); PG8_MMA(1, 1, At, B1); PG8_BAR; PG8_SCHED;
            PG8_LDB(B0, 1, 0); PG8_LDB(B1, 1, 1); PG8_SCHED; PG8_LDA(At, 1, 0); PG8_STAGE(PG8_SA(0, 1), a2 + hstep, voffA);
            PG8_WAIT_V(8); PG8_WAIT_L(0); PG8_BAR; PG8_MMA(0, 0, At, B0); PG8_MMA(0, 1, At, B1); PG8_BAR; PG8_SCHED;
            PG8_LDA(At, 1, 1); PG8_STAGE(PG8_SB(1, 0), b3, voffB); PG8_STAGE(PG8_SB(1, 1), b3 + hstep, voffB); PG8_STAGE(PG8_SA(1, 0), a3, voffA);
            PG8_WAIT_V(8); PG8_WAIT_L(0); PG8_BAR; PG8_MMA(1, 0, At, B0); PG8_MMA(1, 1, At, B1); PG8_BAR; PG8_SCHED;
            } else {
            PG8_LDB(B0, 0, 0); PG8_SCHED; PG8_LDA(At, 0, 0); PG8_STAGE(PG8_SA(1, 1), a1 + hstep, voffA);
            PG8_WAIT_L(8); PG8_BAR; PG8_WAIT_L(0); PG8_MMA(0, 0, At, B0); PG8_BAR; PG8_SCHED;
            PG8_LDB(B1, 0, 1); PG8_STAGE(PG8_SB(0, 0), b2, voffB);
            PG8_BAR; PG8_WAIT_L(0); PG8_MMA(0, 1, At, B1); PG8_BAR;
            PG8_LDA(At, 0, 1); PG8_STAGE(PG8_SA(0, 0), a2, voffA);
            PG8_BAR; PG8_WAIT_L(0); PG8_MMA(1, 0, At, B0); PG8_BAR; PG8_SCHED;
            PG8_STAGE(PG8_SB(0, 1), b2 + hstep, voffB);
            PG8_WAIT_V(6); PG8_BAR; PG8_MMA(1, 1, At, B1); PG8_BAR;
            PG8_LDB(B0, 1, 0); PG8_SCHED; PG8_LDA(At, 1, 0); PG8_STAGE(PG8_SA(0, 1), a2 + hstep, voffA);
            PG8_WAIT_L(8); PG8_BAR; PG8_WAIT_L(0); PG8_MMA(0, 0, At, B0); PG8_BAR; PG8_SCHED;
            PG8_LDB(B1, 1, 1); PG8_STAGE(PG8_SB(1, 0), b3, voffB);
            PG8_BAR; PG8_WAIT_L(0); PG8_MMA(0, 1, At, B1); PG8_BAR;
            PG8_LDA(At, 1, 1); PG8_STAGE(PG8_SA(1, 0), a3, voffA);
            PG8_BAR; PG8_WAIT_L(0); PG8_MMA(1, 0, At, B0); PG8_BAR; PG8_SCHED;
            PG8_STAGE(PG8_SB(1, 1), b3 + hstep, voffB);
            PG8_WAIT_V(6); PG8_BAR; PG8_MMA(1, 1, At, B1); PG8_BAR;
            }
        }
        if constexpr (ALIGN_EPI) { if (wr == 0) PG8_BAR; }
        if constexpr (!Epi::AFTER_DRAIN) { E(acc, cur, wr, wc, fr, fq); S.done(cur); }
        if (!has_next) break;
#pragma unroll
        for (int a = 0; a < 2; ++a)
#pragma unroll
            for (int b = 0; b < 2; ++b)
#pragma unroll
                for (int m = 0; m < 4; ++m)
#pragma unroll
                    for (int n = 0; n < 2; ++n) acc[a][b][m][n] = (f32x4){0.f, 0.f, 0.f, 0.f};
        cur = nxt; cA = nA; cB = nB; ++ui;
        if constexpr (ALIGN_EPI) { if (wr == 1) PG8_BAR; }
    }
    PG8_WAIT_V(0);
    if constexpr (!ALIGN_EPI) { if (wr == 0) PG8_BAR; }
    PG8_BAR;
    if constexpr (Epi::AFTER_DRAIN) { E.fused(acc, cur, wr, wc, fr, fq, lds, wid, lane); S.done(cur); }
#undef PG8_SA
#undef PG8_SB
#undef PG8_STAGE
#undef PG8_LDA
#undef PG8_LDB
#undef PG8_MMA
#undef PG8_WAIT_V
#undef PG8_WAIT_L
#undef PG8_BAR
#undef PG8_SCHED
}
}
#include <hip/hip_bf16.h>
#include <cmath>
namespace attn_body {
using bf16=__hip_bfloat16;
using bf16x8=__attribute__((ext_vector_type(8)))short;
using s16x4=__attribute__((ext_vector_type(4)))short;
using f32x16=__attribute__((ext_vector_type(16)))float;
using u32x4=__attribute__((ext_vector_type(4)))unsigned;
using f32x4_t=__attribute__((ext_vector_type(4)))float;
__device__ __forceinline__ unsigned f2bf_(float f){unsigned u=__builtin_bit_cast(unsigned,f);return (u+0x7fffu+((u>>16)&1u))>>16;}
constexpr int BATCH=1,NHEAD=16,SEQ=16384,D=64,DM=NHEAD*D;
constexpr int NW=8,QBLK=32,QB=QBLK*NW,KVBLK=64,NQB=SEQ/QB;
constexpr int ATTN_PITCH=DM, ATTN_UNIT_ROWS=QB;
__device__ __forceinline__ int crow(int r,int hi){return (r&3)+8*(r>>2)+4*hi;}
#define SBAR() __builtin_amdgcn_sched_barrier(0)
__device__ __forceinline__ void cmask(f32x16&p0,f32x16&p1,int jb,int qrel,int hi){
  const float NEG=-INFINITY; int kb=64*jb+4*hi;
  #pragma unroll
  for(int r=0;r<16;++r){int kv=kb+(r&3)+8*(r>>2); if(kv>qrel)p0[r]=NEG; if(kv+32>qrel)p1[r]=NEG;}
}

constexpr int NSLOT=3, SLOTB=8192;
constexpr int LDS_K=0, LDS_V=NSLOT*SLOTB, LDS_WS=2*NSLOT*SLOTB, LDS_OST=LDS_WS+NW*64*4, LDS_CT=LDS_OST+NW*4096, LDS_BYTES=LDS_CT+SEQ*4;
constexpr float C2=0.125f*1.4426950408889634f;
__device__ __forceinline__ void glds16(const void*gsrc,unsigned lds_dst){unsigned keep;
  asm volatile("s_mov_b32 %0, m0\n\ts_mov_b32 m0, %2\n\ts_nop 0\n\tglobal_load_lds_dwordx4 %1, off\n\ts_mov_b32 m0, %0":"=&s"(keep):"v"(gsrc),"s"(lds_dst):"memory");}
__device__ __forceinline__ float max3f(float a,float b,float c){float r;asm("v_max3_f32 %0, %1, %2, %3":"=v"(r):"v"(a),"v"(b),"v"(c));return r;}
__device__ __forceinline__ float max2f(float a,float b){float r;asm("v_max_f32_e32 %0, %1, %2":"=v"(r):"v"(a),"v"(b));return r;}
__device__ __forceinline__ float fadd_s(float a,float b){float r;asm("v_add_f32_e32 %0, %1, %2":"=v"(r):"v"(a),"v"(b));return r;}
__device__ __forceinline__ float fsub_s(float a,float b){float r;asm("v_sub_f32_e32 %0, %1, %2":"=v"(r):"v"(a),"v"(b));return r;}
typedef float f32x2_t __attribute__((ext_vector_type(2))); typedef __bf16 bf16x2_t __attribute__((ext_vector_type(2)));
__device__ __forceinline__ unsigned cvtpk_s(float lo,float hi){f32x2_t v={lo,hi};bf16x2_t b=__builtin_convertvector(v,bf16x2_t);return __builtin_bit_cast(unsigned,b);}
#define WAIT_BAR(N) asm volatile("s_waitcnt vmcnt(" #N ") lgkmcnt(0)\n\ts_barrier":::"memory")

__device__ __forceinline__ void qkt(f32x16&p0,f32x16&p1,const char*Kslot,const bf16x8*qr,int r32,int hi,bf16x8 kbA,bf16x8 kbB,bf16x8 qx){
  const f32x16 z16=f32x16{};
  p0=__builtin_amdgcn_mfma_f32_32x32x16_bf16(kbA,qx,z16,0,0,0);p1=__builtin_amdgcn_mfma_f32_32x32x16_bf16(kbB,qx,z16,0,0,0);
  const char*kb=Kslot+hi*1024+r32*16;
  #pragma unroll
  for(int d0=0;d0<4;++d0){
    const bf16x8 b0=*reinterpret_cast<const bf16x8*>(kb+d0*2048);
    const bf16x8 b1=*reinterpret_cast<const bf16x8*>(kb+d0*2048+512);
    p0=__builtin_amdgcn_mfma_f32_32x32x16_bf16(b0,qr[d0],p0,0,0,0);p1=__builtin_amdgcn_mfma_f32_32x32x16_bf16(b1,qr[d0],p1,0,0,0);}
}
typedef __attribute__((address_space(3))) const char* lds_cptr;
typedef short v4i16_t __attribute__((ext_vector_type(4)));
__device__ __forceinline__ void kload8(bf16x8*kf,lds_cptr kp){
  kf[0]=*(const __attribute__((address_space(3))) bf16x8*)(kp);      kf[1]=*(const __attribute__((address_space(3))) bf16x8*)(kp+512);
  kf[2]=*(const __attribute__((address_space(3))) bf16x8*)(kp+2048); kf[3]=*(const __attribute__((address_space(3))) bf16x8*)(kp+2560);
  kf[4]=*(const __attribute__((address_space(3))) bf16x8*)(kp+4096); kf[5]=*(const __attribute__((address_space(3))) bf16x8*)(kp+4608);
  kf[6]=*(const __attribute__((address_space(3))) bf16x8*)(kp+6144); kf[7]=*(const __attribute__((address_space(3))) bf16x8*)(kp+6656);
}
__device__ __forceinline__ void kload2(bf16x8*kf,lds_cptr kp,int j){ kf[2*j]=*(const __attribute__((address_space(3))) bf16x8*)(kp+j*2048); kf[2*j+1]=*(const __attribute__((address_space(3))) bf16x8*)(kp+j*2048+512); }
__device__ __forceinline__ s16x4 vtr(lds_cptr p){ return __builtin_bit_cast(s16x4,__builtin_amdgcn_ds_read_tr16_b64_v4i16((__attribute__((address_space(3))) v4i16_t*)p)); }
__device__ __forceinline__ float rowmax(const f32x16&p0,const f32x16&p1){
  float a=max3f(p0[0],p0[1],p1[0]),b=max3f(p0[2],p0[3],p1[1]);a=max3f(a,p1[2],p1[3]);
  #pragma unroll
  for(int r=4;r<16;r+=4){a=max3f(a,p0[r],p0[r+1]);b=max3f(b,p0[r+2],p0[r+3]);a=max3f(a,p1[r],p1[r+1]);b=max3f(b,p1[r+2],p1[r+3]);}
  const float m=max2f(a,b);
  auto rr=__builtin_amdgcn_permlane32_swap(__float_as_uint(m),__float_as_uint(m),false,false);
  return max2f(__uint_as_float(rr[0]),__uint_as_float(rr[1]));
}
__device__ __forceinline__ void pv(f32x16*o,int vb,bf16x8 pa0,bf16x8 pa1,bf16x8 pa2,bf16x8 pa3){
  #pragma unroll
  for(int d0=0;d0<2;++d0){s16x4 lo[4],hi[4];
    #pragma unroll
    for(int ks=0;ks<4;++ks){
      asm volatile("ds_read_b64_tr_b16 %0,%1 offset:%c2":"=&v"(lo[ks]):"v"(vb),"i"(d0*4096+ks*1024):"memory");
      asm volatile("ds_read_b64_tr_b16 %0,%1 offset:%c2":"=&v"(hi[ks]):"v"(vb),"i"(d0*4096+ks*1024+512):"memory");}
    asm volatile("s_waitcnt lgkmcnt(0)":::"memory");SBAR();
    #define PK(k) (bf16x8){lo[k][0],lo[k][1],lo[k][2],lo[k][3],hi[k][0],hi[k][1],hi[k][2],hi[k][3]}
    o[d0]=__builtin_amdgcn_mfma_f32_32x32x16_bf16(pa0,PK(0),o[d0],0,0,0);
    o[d0]=__builtin_amdgcn_mfma_f32_32x32x16_bf16(pa1,PK(1),o[d0],0,0,0);
    o[d0]=__builtin_amdgcn_mfma_f32_32x32x16_bf16(pa2,PK(2),o[d0],0,0,0);
    o[d0]=__builtin_amdgcn_mfma_f32_32x32x16_bf16(pa3,PK(3),o[d0],0,0,0);
    #undef PK
  }
}

#ifndef ATTN_STORE16
#define ATTN_STORE16(p,v) (*(u32x4*)(p)=(v))
#endif
template<int THRL> __device__ __forceinline__ void attn_unit(int b,int h,int qb,const bf16*Q,const bf16*__restrict__ K,const bf16*__restrict__ V,bf16*O,char*shm,const float*__restrict__ cbh,int tskip){
  int tid_=threadIdx.x; asm volatile("":"+v"(tid_));
  const int tid=tid_,lane=tid&63,r32=lane&31,hi=lane>>5; const int wid=__builtin_amdgcn_readfirstlane(tid>>6);
  const long rowbase=(long)b*SEQ; const int q0=qb*QB;
  const bf16*Qw=Q+(rowbase+q0+wid*QBLK)*DM+h*D;
  const bf16*Kh=K+rowbase*DM+h*D,*Vh=V+rowbase*DM+h*D;
  const unsigned lds0=(unsigned)(uintptr_t)shm;
  float*wsf=(float*)(shm+LDS_WS)+wid*64;
  const bf16*ksrc=Kh+(long)lane*DM+wid*8;
  const bf16*vsrc=Vh+(long)(16*(wid&3)+(lane>>2))*DM+(wid>>2)*32+(lane&3)*8;
  const unsigned kdst=lds0+LDS_K+wid*1024, vdst=lds0+LDS_V+wid*1024;
  #define DMA_K(t,slot) glds16(ksrc+(long)(t)*KVBLK*DM,(unsigned)__builtin_amdgcn_readfirstlane(kdst+(slot)))
  #define DMA_V(t,slot) glds16(vsrc+(long)(t)*KVBLK*DM,(unsigned)__builtin_amdgcn_readfirstlane(vdst+(slot)))
  const int vb0=(int)(lds0+LDS_V)+((lane>>4)&1)*32+(lane&3)*8+(4*hi+((lane&15)>>2))*64;
  const char*Kbase=shm+LDS_K; bf16x8 kf[8];
  const lds_cptr shm3=(lds_cptr)shm; const lds_cptr kp0=shm3+LDS_K+hi*1024+r32*16; const lds_cptr vp0=shm3+LDS_V+((lane>>4)&1)*32+(lane&3)*8+(4*hi+((lane&15)>>2))*64;
  const int NT=(q0+QB)/KVBLK-tskip;
  { typedef __attribute__((address_space(3))) f32x4_t* l4p; const l4p ct4=(l4p)(shm3+LDS_CT); const f32x4_t* g4=(const f32x4_t*)cbh;
    (void)ct4; (void)g4; const float cref=cbh[q0+QB-1-tskip*KVBLK]; __attribute__((address_space(3))) unsigned* ctw=(__attribute__((address_space(3))) unsigned*)(shm3+LDS_CT);
    for(int i0=tid;i0<NT*64;i0+=NW*64*8){ float vv_[8];
      #pragma unroll
      for(int u_=0;u_<8;++u_){ const int i=i0+u_*NW*64; vv_[u_]=(i<NT*64)?cbh[i]:0.f; }
      #pragma unroll
      for(int u_=0;u_<8;++u_){ const int i=i0+u_*NW*64; if(i<NT*64){ const float v_=__builtin_fmaxf(vv_[u_]-cref,-240.f); const unsigned u1=f2bf_(v_); const float r1_=v_-__uint_as_float(u1<<16); const unsigned u2=f2bf_(r1_); ctw[i]=u1|(u2<<16); } } }
    asm volatile("s_waitcnt vmcnt(0) lgkmcnt(0)\n\ts_barrier":::"memory"); }
  const __attribute__((address_space(3))) unsigned* ctab=(const __attribute__((address_space(3))) unsigned*)(shm3+LDS_CT)+r32;
  #define MKQX(mv) ({ const float c_=(mv); const unsigned u1=f2bf_(c_); const float r1_=c_-__uint_as_float(u1<<16); const unsigned u2=f2bf_(r1_); const float r2_=r1_-__uint_as_float(u2<<16); const unsigned u3=f2bf_(r2_); u32x4 t_={0x3F803F80u,0x00003F80u|(u1<<16),u2|(u3<<16),0u}; if(hi){t_=(u32x4){0u,0u,0u,0u};} __builtin_bit_cast(bf16x8,t_); })
  bf16x8 qx=MKQX(0.f);
  #define KBIAS(cv) ({ u32x4 t_={(cv),0x3F800000u,0x3F803F80u,0u}; __builtin_bit_cast(bf16x8,t_); })
  DMA_K(0,0);DMA_V(0,0);DMA_K(1,SLOTB);
  bf16x8 qr[4];
  #pragma unroll
  for(int d0=0;d0<4;++d0)qr[d0]=*reinterpret_cast<const bf16x8*>(&Qw[(long)r32*DM+d0*16+hi*8]);
  float mhat=0.f,l_reg=0.f;f32x16 o[2];o[0]=f32x16{};o[1]=f32x16{};
  const int qrel=wid*QBLK+r32;
  #define CMASK(P0,P1,t) do{int jb_=(t)-(NT-4); if(jb_>=0)cmask(P0,P1,jb_,qrel,hi);}while(0)
  bool resc=false;
  #define START(P0,P1) do{ const float rm=rowmax(P0,P1); resc=false; \
    { const float dl=rm; mhat=fadd_s(mhat,dl); \
      _Pragma("unroll") for(int r=0;r<16;++r){P0[r]=fsub_s(P0[r],dl);P1[r]=fsub_s(P1[r],dl);} \
      qx=MKQX(-mhat); } \
    _Pragma("unroll") for(int r=0;r<16;++r)P0[r]=__builtin_amdgcn_exp2f(P0[r]); }while(0)
  #define RESC() do{ if(resc){ asm volatile("s_waitcnt lgkmcnt(0)":::"memory"); \
      _Pragma("unroll") for(int d_=0;d_<2;++d_) _Pragma("unroll") for(int r=0;r<16;++r)o[d_][r]*=wsf[crow(r,hi)]; } }while(0)
  f32x16 pA0,pA1,pB0,pB1;
  int sl_prev=0,sl_cur=0,sl_next=SLOTB;
  #define ROT() do{sl_prev=sl_cur;sl_cur=sl_next;sl_next=(sl_next==(NSLOT-1)*SLOTB)?0:sl_next+SLOTB;}while(0)
  DMA_K(2,2*SLOTB);
  WAIT_BAR(3);
  qkt(pA0,pA1,Kbase,qr,r32,hi,KBIAS(ctab[0]),KBIAS(ctab[32]),qx);asm volatile("s_nop 15\n\ts_nop 7":"+v"(pA0),"+v"(pA1));CMASK(pA0,pA1,0);
  START(pA0,pA1);
  _Pragma("unroll") for(int r=0;r<16;++r)pA1[r]=__builtin_amdgcn_exp2f(pA1[r]);
  WAIT_BAR(0);
  DMA_K(3,0);DMA_V(1,SLOTB);
  ROT();
  kload8(kf,kp0+sl_cur);
  WAIT_BAR(2);
  s16x4 vlo[8],vhi[8]; u32x4 pw0,pw1,pw2,pw3;
  #define PKW(P,B) cvtpk_s(P[B],P[B+1])
  #define PAF(k) __builtin_bit_cast(bf16x8,pw##k)
  #define VFR(i) (bf16x8){vlo[i][0],vlo[i][1],vlo[i][2],vlo[i][3],vhi[i][0],vhi[i][1],vhi[i][2],vhi[i][3]}
  #define PIN(x) asm volatile("":"+v"(x))
  #define MX3(a,b,c) __builtin_fmaxf(__builtin_fmaxf((a),(b)),(c))
  #define GAPA(MF,A0,A1,A2,A3,W0,W1,PW) do{ MF; sacc+=A0; sacc+=A1; sacc+=A2; sacc+=A3; PIN(sacc); W0; W1; PIN(PW); SBAR(); }while(0)
  #define EX(v) __builtin_amdgcn_exp2f(v)
  #define GAPB(MF,X,B) do{ MF; X[B]=EX(X[B]); X[B+1]=EX(X[B+1]); X[B+2]=EX(X[B+2]); X[B+3]=EX(X[B+3]); PIN(X); SBAR(); }while(0)
  #define VRD(i) do{ vlo[i]=vtr(vp_+(((i)>>2)*4096+((i)&3)*1024)); vhi[i]=vtr(vp_+(((i)>>2)*4096+((i)&3)*1024+512)); }while(0)
  #define KRD(G,j) do{ if(G){ kload2(kf,kp0+sl_next,j); SBAR(); } }while(0)
  #define STEP(C0,C1,P0,P1,t,GK,GV,GL) do{ SBAR(); \
    const lds_cptr vp_=vp0+sl_prev; \
    const f32x16 z16_=f32x16{}; \
    VRD(0); SBAR(); float sacc=(P0[0]+P0[1]); \
    GAPA(C0=__builtin_amdgcn_mfma_f32_32x32x16_bf16(kf[0],qr[0],z16_,0,0,0), P0[2],P0[3],P0[4],P0[5],     pw0[0]=PKW(P0,0), pw0[1]=PKW(P0,2), pw0); \
    VRD(4); SBAR(); GAPA(C1=__builtin_amdgcn_mfma_f32_32x32x16_bf16(kf[1],qr[0],z16_,0,0,0), P0[6],P0[7],P0[8],P0[9],     pw0[2]=PKW(P0,4), pw0[3]=PKW(P0,6), pw0); \
    VRD(1); SBAR(); GAPA(C0=__builtin_amdgcn_mfma_f32_32x32x16_bf16(kf[2],qr[1],C0,0,0,0),   P0[10],P0[11],P0[12],P0[13], pw1[0]=PKW(P0,8), pw1[1]=PKW(P0,10), pw1); \
    VRD(5); SBAR(); GAPA(C1=__builtin_amdgcn_mfma_f32_32x32x16_bf16(kf[3],qr[1],C1,0,0,0),   P0[14],P0[15],P1[0],P1[1],   pw1[2]=PKW(P0,12),pw1[3]=PKW(P0,14), pw1); \
    VRD(2); SBAR(); GAPA(C0=__builtin_amdgcn_mfma_f32_32x32x16_bf16(kf[4],qr[2],C0,0,0,0),   P1[2],P1[3],P1[4],P1[5],     pw2[0]=PKW(P1,0), pw2[1]=PKW(P1,2), pw2); \
    VRD(6); SBAR(); GAPA(C1=__builtin_amdgcn_mfma_f32_32x32x16_bf16(kf[5],qr[2],C1,0,0,0),   P1[6],P1[7],P1[8],P1[9],     pw2[2]=PKW(P1,4), pw2[3]=PKW(P1,6), pw2); \
    VRD(3); SBAR(); GAPA(C0=__builtin_amdgcn_mfma_f32_32x32x16_bf16(kf[6],qr[3],C0,0,0,0),   P1[10],P1[11],P1[12],P1[13], pw3[0]=PKW(P1,8), pw3[1]=PKW(P1,10), pw3); \
    VRD(7); SBAR(); GAPA(C1=__builtin_amdgcn_mfma_f32_32x32x16_bf16(kf[7],qr[3],C1,0,0,0),   P1[14],P1[15],0.f,0.f,       pw3[2]=PKW(P1,12),pw3[3]=PKW(P1,14), pw3); \
    { const bf16x8 kbA_=KBIAS(ctab[(t)*64]), kbB_=KBIAS(ctab[(t)*64+32]); C0=__builtin_amdgcn_mfma_f32_32x32x16_bf16(kbA_,qx,C0,0,0,0); C1=__builtin_amdgcn_mfma_f32_32x32x16_bf16(kbB_,qx,C1,0,0,0); } SBAR(); \
    l_reg+=sacc; \
    if(GK){DMA_K((t)+3,sl_cur);} if(GV){DMA_V((t)+1,sl_next);} \
    CMASK(C0,C1,t); \
    { float a=MX3(C0[0],C0[1],C1[0]),b=MX3(C0[2],C0[3],C1[1]); a=MX3(a,C1[2],C1[3]); \
      _Pragma("unroll") for(int r=4;r<16;r+=4){a=MX3(a,C0[r],C0[r+1]);b=MX3(b,C0[r+2],C0[r+3]);a=MX3(a,C1[r],C1[r+1]);b=MX3(b,C1[r+2],C1[r+3]);} \
      float rm=__builtin_fmaxf(a,b); { auto rr=__builtin_amdgcn_permlane32_swap(__float_as_uint(rm),__float_as_uint(rm),false,false); rm=__builtin_fmaxf(__uint_as_float(rr[0]),__uint_as_float(rr[1])); } \
      resc=false; \
      if(__builtin_expect(__any(rm>(float)THRL),0)){ const float dl=__builtin_fmaxf(rm,0.f); mhat+=dl; \
        _Pragma("unroll") for(int r=0;r<16;++r){C0[r]-=dl;C1[r]-=dl;} \
        qx=MKQX(-mhat); \
        const float f=__builtin_amdgcn_exp2f(-dl); l_reg*=f; if(hi==0)wsf[r32]=f; resc=true; } } \
    SBAR(); \
    GAPB(o[0]=__builtin_amdgcn_mfma_f32_32x32x16_bf16(PAF(0),VFR(0),o[0],0,0,0), C0,0); \
    GAPB(o[1]=__builtin_amdgcn_mfma_f32_32x32x16_bf16(PAF(0),VFR(4),o[1],0,0,0), C0,4); \
    KRD(GL,0); GAPB(o[0]=__builtin_amdgcn_mfma_f32_32x32x16_bf16(PAF(1),VFR(1),o[0],0,0,0), C0,8); \
    KRD(GL,1); GAPB(o[1]=__builtin_amdgcn_mfma_f32_32x32x16_bf16(PAF(1),VFR(5),o[1],0,0,0), C0,12); \
    KRD(GL,2); GAPB(o[0]=__builtin_amdgcn_mfma_f32_32x32x16_bf16(PAF(2),VFR(2),o[0],0,0,0), C1,0); \
    KRD(GL,3); GAPB(o[1]=__builtin_amdgcn_mfma_f32_32x32x16_bf16(PAF(2),VFR(6),o[1],0,0,0), C1,4); \
    GAPB(o[0]=__builtin_amdgcn_mfma_f32_32x32x16_bf16(PAF(3),VFR(3),o[0],0,0,0), C1,8); \
    GAPB(o[1]=__builtin_amdgcn_mfma_f32_32x32x16_bf16(PAF(3),VFR(7),o[1],0,0,0), C1,12); \
    }while(0)
  int t=1;
  #undef CMASK
  #define CMASK(P0,P1,t) do{}while(0)
  for(;t+5<NT;t+=2){
    STEP(pB0,pB1,pA0,pA1,t,true,true,true);     WAIT_BAR(2); RESC(); ROT();
    STEP(pA0,pA1,pB0,pB1,t+1,true,true,true);   WAIT_BAR(2); RESC(); ROT();
  }
  #undef CMASK
  #define CMASK(P0,P1,t) do{int jb_=(t)-(NT-4); if(jb_>=0)cmask(P0,P1,jb_,qrel,hi);}while(0)
  #define ENDW(tt) do{ if((tt)+3<NT){WAIT_BAR(2);} else if((tt)+2<NT){WAIT_BAR(1);} else {WAIT_BAR(0);} }while(0)
  for(;t+1<NT;t+=2){
    STEP(pB0,pB1,pA0,pA1,t,(t+3<NT),(t+1<NT),(t+1<NT));       ENDW(t);   RESC(); ROT();
    STEP(pA0,pA1,pB0,pB1,t+1,(t+4<NT),(t+2<NT),(t+2<NT));     ENDW(t+1); RESC(); ROT();
  }
  STEP(pB0,pB1,pA0,pA1,NT-1,false,false,false); RESC();
  { float sacc=pB0[0]+pB0[1]; _Pragma("unroll") for(int r=2;r<16;++r)sacc+=pB0[r]; _Pragma("unroll") for(int r=0;r<16;++r)sacc+=pB1[r]; l_reg+=sacc;
    pw0=(u32x4){PKW(pB0,0),PKW(pB0,2),PKW(pB0,4),PKW(pB0,6)};pw1=(u32x4){PKW(pB0,8),PKW(pB0,10),PKW(pB0,12),PKW(pB0,14)};pw2=(u32x4){PKW(pB1,0),PKW(pB1,2),PKW(pB1,4),PKW(pB1,6)};pw3=(u32x4){PKW(pB1,8),PKW(pB1,10),PKW(pB1,12),PKW(pB1,14)};
    SBAR(); pv(o,vb0+sl_cur,PAF(0),PAF(1),PAF(2),PAF(3)); }
  #undef PKW
  #undef PAF
  #undef VFR
  #undef PIN
  #undef MX3
  #undef GAPA
  #undef GAPB
  #undef EX
  #undef VRD
  #undef KRD
  #undef STEP
  #undef ENDW
  {auto rr=__builtin_amdgcn_permlane32_swap(__float_as_uint(l_reg),__float_as_uint(l_reg),false,false);l_reg=__uint_as_float(rr[0])+__uint_as_float(rr[1]);}
  if(hi==0)wsf[32+r32]=l_reg;asm volatile("s_waitcnt lgkmcnt(0)":::"memory");
  float rli[16];
  #pragma unroll
  for(int r=0;r<16;++r)rli[r]=__builtin_amdgcn_rcpf(wsf[32+crow(r,hi)]);
  bf16*Ow=O+(rowbase+q0+wid*QBLK)*DM+h*D;
  { bf16*stg=(bf16*)(shm+LDS_OST)+wid*2048;
    #pragma unroll
    for(int r=0;r<16;++r){const int orow=crow(r,hi);
      #pragma unroll
      for(int d0=0;d0<2;++d0)stg[orow*64+d0*32+r32]=__float2bfloat16(o[d0][r]*rli[r]);}
    asm volatile("s_waitcnt lgkmcnt(0)":::"memory");
    #pragma unroll
    for(int i=0;i<4;++i){const int row=i*8+(lane>>3),ch=lane&7; const u32x4 v=*(const u32x4*)(stg+row*64+ch*8); ATTN_STORE16(Ow+(long)row*DM+ch*8,v);} }
  asm volatile("s_waitcnt lgkmcnt(0)\n\ts_barrier":::"memory");
  #undef KBIAS
  #undef MKQX
  #undef DMA_K
  #undef DMA_V
  #undef CMASK
  #undef START
  #undef RESC
  #undef ROT
}
constexpr int ATTN_LDS_BYTES=LDS_BYTES;
struct AttnTensors { const bf16* Q; const bf16* K; const bf16* V; bf16* O; };
struct AttnUnit { int bh; int qb; };
struct StaticOrder {
  int G,c;
  __device__ __forceinline__ StaticOrder(int grid,int block):G(grid),c(block){}
  __device__ __forceinline__ bool next(int i,AttnUnit&u)const{ const int j=i*G+((i&1)?(G-1-c):c); if(j>=NHEAD*NQB)return false; u.bh=j%NHEAD; u.qb=NQB-1-j/NHEAD; return true; }
  __device__ __forceinline__ void a_ready(const AttnUnit&)const{}
  __device__ __forceinline__ void done(const AttnUnit&)const{}
};
constexpr float SKIP_T=40.f;
template<class Sched,int THRL=8> __device__ __forceinline__ void attn_phase(char*lds,const AttnTensors&T,const Sched&S,const float*cb,const float*nrm){
  AttnUnit u; const int tid=threadIdx.x;
  __attribute__((address_space(3))) int* redi=(__attribute__((address_space(3))) int*)((lds_cptr)lds+LDS_CT);
  for(int i=0;S.next(i,u);++i){ S.a_ready(u);
    const int h=u.bh%NHEAD, q0=u.qb*QB, NT0=(q0+QB)/KVBLK; const float* cbh=cb+(long)h*SEQ; const float* qn=nrm+h*(SEQ/KVBLK)+4*u.qb; const float* kn=nrm+NHEAD*(SEQ/KVBLK)+h*(SEQ/KVBLK);
    int tt=tid; asm volatile("":"+v"(tt));
    const float qmx=__builtin_fmaxf(__builtin_fmaxf(qn[0],qn[1]),__builtin_fmaxf(qn[2],qn[3]));
    const float kdg=__builtin_fmaxf(__builtin_fmaxf(kn[4*u.qb],kn[4*u.qb+1]),__builtin_fmaxf(kn[4*u.qb+2],kn[4*u.qb+3]));
    if(tid==0) redi[0]=NT0;
    asm volatile("s_waitcnt vmcnt(0) lgkmcnt(0)\n\ts_barrier":::"memory");
    if(tt<NT0){ const bool skip_=(cbh[(unsigned)(tt*KVBLK+KVBLK-1)]-cbh[q0]+qmx*(kn[(unsigned)tt]+kdg))<-SKIP_T; if(!skip_) __hip_atomic_fetch_min(redi,tt,__ATOMIC_RELAXED,__HIP_MEMORY_SCOPE_WORKGROUP); }
    asm volatile("s_waitcnt vmcnt(0) lgkmcnt(0)\n\ts_barrier":::"memory");
    int tskip=redi[0]; tskip=tskip<NT0-8?tskip:NT0-8; tskip=tskip>0?(tskip&~1):0; tskip=__builtin_amdgcn_readfirstlane(tskip);
    asm volatile("s_waitcnt lgkmcnt(0)\n\ts_barrier":::"memory");
    attn_unit<THRL>(u.bh/NHEAD,h,u.qb,T.Q,T.K+(long)tskip*KVBLK*DM,T.V+(long)tskip*KVBLK*DM,T.O,lds,cbh+tskip*KVBLK,tskip); S.done(u); }
}
#undef SBAR
#undef WAIT_BAR
}
#define LAS __attribute__((address_space(3)))
typedef unsigned short bf16_t;
typedef short bf16x8 __attribute__((ext_vector_type(8)));
typedef short s16x4 __attribute__((ext_vector_type(4)));
typedef float f32x4 __attribute__((ext_vector_type(4)));
typedef unsigned u32x4 __attribute__((ext_vector_type(4)));
typedef unsigned u32x2 __attribute__((ext_vector_type(2)));

constexpr int MP = 16384, MS = 512, M = MP + MS, DM = 1024;
constexpr int DI = 2048, CONVD = 3072, NIN = 5152, NIN_PAD = 5376, NHM = 32;
constexpr int DFF = 2816, NUP = 5632, NQ = 3328, NH = 16;
constexpr int NSB = 32, SL = 16, PAST = 1024, KL = PAST + SL;
constexpr float EPS = 1e-6f, LOG2E = 1.4426950408889634f, C2Q = 0.125f * 1.4426950408889634f;
constexpr int NCH = MP / 64;
constexpr size_t O_Y = 0, O_PSSM = (size_t)M * DM, O_PMC = O_PSSM + 32 * 64 * 128, O_PFC = O_PMC + 3 * CONVD, O_PK = O_PFC + 2 * 2 * NUP,
                 O_PV = O_PK + (size_t)MP * DM, O_PLF = O_PV + (size_t)MP * DM, O_SSSM = O_PLF + (size_t)MP * NH, O_SMC = O_SSSM + (size_t)NSB * 32 * 64 * 128,
                 O_SFC = O_SMC + (size_t)NSB * 3 * CONVD, O_SK = O_SFC + (size_t)2 * NSB * 2 * NUP, O_SV = O_SK + (size_t)MS * DM, O_SLF = O_SV + (size_t)MS * DM,
                 O_END = O_SLF + (size_t)MS * NH;
constexpr size_t al(size_t x) { return (x + 255) & ~(size_t)255; }
constexpr size_t WS_BAR = 0;
constexpr size_t WS_NRM = 16384;
constexpr size_t WS_SSQ = 16384 + 65536;
constexpr size_t WS_DT = WS_SSQ + al((size_t)4 * M * 16 * 4);
constexpr size_t WS_DEC = WS_DT + al((size_t)M * 32 * 4);
constexpr size_t WS_CB = WS_DEC + al((size_t)NCH * 32 * 4);
constexpr size_t WS_CS = WS_CB + al((size_t)NH * MP * 4);
constexpr size_t WS_WIN = WS_CS + al((size_t)NSB * NH * KL * 4);
constexpr size_t WS_WOUT = WS_WIN + al((size_t)NIN_PAD * DM * 2);
constexpr size_t WS_WUP = WS_WOUT + al((size_t)DM * DI * 2);
constexpr size_t WS_WDN = WS_WUP + al((size_t)2 * NUP * DM * 2);
constexpr size_t WS_WQ = WS_WDN + al((size_t)2 * DM * DFF * 2);
constexpr size_t WS_WO = WS_WQ + al((size_t)NQ * DM * 2);
constexpr size_t WS_HB = WS_WO + al((size_t)DM * DM * 2);
constexpr size_t WS_S0 = WS_HB + al((size_t)M * DM * 2);
constexpr size_t WS_ZB = WS_S0;
constexpr size_t WS_X1 = WS_ZB + al((size_t)M * DI * 2);
constexpr size_t WS_X2 = WS_X1 + al((size_t)M * CONVD * 2);
constexpr size_t WS_ST = WS_X2 + al((size_t)M * CONVD * 2);
constexpr size_t WS_END1 = WS_ST + al((size_t)NCH * 32 * 8192 * 2);
constexpr size_t WS_UP = WS_S0;
constexpr size_t WS_EDGE = WS_UP;
constexpr size_t WS_UPS = WS_EDGE + al((size_t)(M / 64) * 4 * NUP * 4);
constexpr size_t WS_G = WS_UP + al((size_t)M * NUP * 2);
constexpr size_t WS_QB = WS_G + al((size_t)M * DFF * 2);
constexpr size_t WS_KB = WS_QB + al((size_t)M * DM * 2);
constexpr size_t WS_VB = WS_KB + al((size_t)M * DM * 2);
constexpr size_t WS_END2 = WS_VB + al((size_t)M * DM * 2);
constexpr size_t WS_NEED = WS_END1 > WS_END2 ? WS_END1 : WS_END2;

constexpr int NT_ = 512, NW_ = 8;
constexpr int LDS_TOTAL = 151552;

struct Args { const float* in[30]; float* out; unsigned char* ws; int ph_lo, ph_hi; };

__device__ __forceinline__ unsigned f2bf(float f) { unsigned u = __builtin_bit_cast(unsigned, f); return (u + 0x7fffu + ((u >> 16) & 1u)) >> 16; }
__device__ __forceinline__ unsigned pk2(float lo, float hi) { typedef float f2 __attribute__((ext_vector_type(2))); typedef __bf16 b2 __attribute__((ext_vector_type(2))); f2 v = {lo, hi}; b2 b = __builtin_convertvector(v, b2); return __builtin_bit_cast(unsigned, b); }
__device__ __forceinline__ float bflo(unsigned u) { return __uint_as_float(u << 16); }
__device__ __forceinline__ float bfhi(unsigned u) { return __uint_as_float(u & 0xffff0000u); }
__device__ __forceinline__ float bf1(bf16_t u) { return __uint_as_float((unsigned)u << 16); }
__device__ __forceinline__ void unpack8(u32x4 v, float* f) { f[0] = bflo(v.x); f[1] = bfhi(v.x); f[2] = bflo(v.y); f[3] = bfhi(v.y); f[4] = bflo(v.z); f[5] = bfhi(v.z); f[6] = bflo(v.w); f[7] = bfhi(v.w); }
__device__ __forceinline__ u32x4 pack8(const float* f) { u32x4 o; o.x = pk2(f[0], f[1]); o.y = pk2(f[2], f[3]); o.z = pk2(f[4], f[5]); o.w = pk2(f[6], f[7]); return o; }
__device__ __forceinline__ float wave_sum(float v) {
#pragma unroll
    for (int o = 1; o < 64; o <<= 1) v += __shfl_xor(v, o);
    return v; }
__device__ __forceinline__ float wave_max(float v) {
#pragma unroll
    for (int o = 1; o < 64; o <<= 1) v = fmaxf(v, __shfl_xor(v, o));
    return v; }
__device__ __forceinline__ float wave_incl_scan(float v, int lane) {
#pragma unroll
    for (int o = 1; o < 64; o <<= 1) { const float t = __shfl_up(v, o); if (lane >= o) v += t; }
    return v; }
__device__ __forceinline__ float silu(float x) { return x * __builtin_amdgcn_rcpf(1.f + __builtin_amdgcn_exp2f(-1.4426950408889634f * x)); }
__device__ __forceinline__ float row_rs(const float* ssq, int row) { return rsqrtf(ssq[(unsigned)row] * (1.f / DM) + EPS); }

using pg8::Unit;
struct EpiIn {
    static constexpr bool PERM = true, AFTER_DRAIN = false;
    const float* ssq; bf16_t* zb; bf16_t* x1; float* dtr;
    __device__ __forceinline__ void operator()(const f32x4 (&acc)[2][2][4][2], const Unit& u, int wr, int wc, int fr, int fq) const {
#pragma unroll
        for (int ai = 0; ai < 2; ++ai)
#pragma unroll
            for (int m = 0; m < 4; ++m) { const int row = u.pm * 256 + ai * 128 + wr * 64 + m * 16 + fr; const float rs = row_rs(ssq, row);
#pragma unroll
                for (int bj = 0; bj < 2; ++bj) { const int col = u.pn * 256 + bj * 128 + wc * 32 + 8 * fq; const f32x4 v0 = acc[ai][bj][m][0] * rs, v1 = acc[ai][bj][m][1] * rs;
                    u32x4 w; w.x = pk2(v0[0], v0[1]); w.y = pk2(v0[2], v0[3]); w.z = pk2(v1[0], v1[1]); w.w = pk2(v1[2], v1[3]);
                    if (u.pn < 8) *(u32x4*)(zb + (size_t)row * DI + col) = w;
                    else if (u.pn < 20) *(u32x4*)(x1 + (size_t)row * CONVD + (col - DI)) = w;
                    else if (col < NIN) { float* d = dtr + (size_t)row * 32 + (col - DI - CONVD); *(f32x4*)d = v0; *(f32x4*)(d + 4) = v1; } } }
    }
};
struct EpiRes {
    static constexpr bool PERM = true, AFTER_DRAIN = false;
    float* hf; bf16_t* hb; float* ssq; const float* xin;
    __device__ __forceinline__ void operator()(const f32x4 (&acc)[2][2][4][2], const Unit& u, int wr, int wc, int fr, int fq) const {
#pragma unroll
        for (int ai = 0; ai < 2; ++ai)
#pragma unroll
            for (int m = 0; m < 4; ++m) { const int row = u.pm * 256 + ai * 128 + wr * 64 + m * 16 + fr; float sq = 0.f;
#pragma unroll
                for (int bj = 0; bj < 2; ++bj) { const int col = u.pn * 256 + bj * 128 + wc * 32 + 8 * fq; bf16_t* hp = hb + (size_t)row * DM + col;
                    f32x4 v0, v1;
                    if (xin) { const float* rp = xin + (size_t)row * DM + col; v0 = *(const f32x4*)rp; v1 = *(const f32x4*)(rp + 4); }
                    else { float f[8]; unpack8(*(const u32x4*)hp, f); v0 = (f32x4){f[0], f[1], f[2], f[3]}; v1 = (f32x4){f[4], f[5], f[6], f[7]}; }
                    v0 += acc[ai][bj][m][0]; v1 += acc[ai][bj][m][1];
                    u32x4 w; w.x = pk2(v0[0], v0[1]); w.y = pk2(v0[2], v0[3]); w.z = pk2(v1[0], v1[1]); w.w = pk2(v1[2], v1[3]);
                    *(u32x4*)hp = w;
                    sq += (v0[0] * v0[0] + v0[1] * v0[1]) + (v0[2] * v0[2] + v0[3] * v0[3]) + (v1[0] * v1[0] + v1[1] * v1[1]) + (v1[2] * v1[2] + v1[3] * v1[3]); }
                sq += __shfl_xor(sq, 16); sq += __shfl_xor(sq, 32);
                if (fq == 0) atomicAdd(ssq + row, sq); }
    }
};
struct EpiUp {
    static constexpr bool PERM = true, AFTER_DRAIN = false;
    const float* ssq; bf16_t* up;
    __device__ __forceinline__ void operator()(const f32x4 (&acc)[2][2][4][2], const Unit& u, int wr, int wc, int fr, int fq) const {
#pragma unroll
        for (int ai = 0; ai < 2; ++ai)
#pragma unroll
            for (int m = 0; m < 4; ++m) { const int row = u.pm * 256 + ai * 128 + wr * 64 + m * 16 + fr; const float rs = row_rs(ssq, row);
#pragma unroll
                for (int bj = 0; bj < 2; ++bj) { const int col = u.pn * 256 + bj * 128 + wc * 32 + 8 * fq; const f32x4 v0 = acc[ai][bj][m][0] * rs, v1 = acc[ai][bj][m][1] * rs;
                    u32x4 w; w.x = pk2(v0[0], v0[1]); w.y = pk2(v0[2], v0[3]); w.z = pk2(v1[0], v1[1]); w.w = pk2(v1[2], v1[3]);
                    *(u32x4*)(up + (size_t)row * NUP + col) = w; } }
    }
};
struct EpiQkv {
    static constexpr bool PERM = true, AFTER_DRAIN = false;
    const float* ssq; bf16_t* qb; bf16_t* kb; bf16_t* vb; float* out; const float* bfv;
    __device__ __forceinline__ void operator()(const f32x4 (&acc)[2][2][4][2], const Unit& u, int wr, int wc, int fr, int fq) const {
        const int sec = u.pn >> 2;
#pragma unroll
        for (int ai = 0; ai < 2; ++ai)
#pragma unroll
            for (int m = 0; m < 4; ++m) { const int row = u.pm * 256 + ai * 128 + wr * 64 + m * 16 + fr; float rs = row_rs(ssq, row); if (sec == 0) rs *= C2Q;
#pragma unroll
                for (int bj = 0; bj < 2; ++bj) { const int col = (u.pn & 3) * 256 + bj * 128 + wc * 32 + 8 * fq; const f32x4 v0 = acc[ai][bj][m][0] * rs, v1 = acc[ai][bj][m][1] * rs;
                    u32x4 w; w.x = pk2(v0[0], v0[1]); w.y = pk2(v0[2], v0[3]); w.z = pk2(v1[0], v1[1]); w.w = pk2(v1[2], v1[3]);
                    if (sec == 0) *(u32x4*)(qb + (size_t)row * DM + col) = w;
                    else if (sec < 3) { *(u32x4*)((sec == 1 ? kb : vb) + (size_t)row * DM + col) = w;
                        float* o = (row < MP) ? out + (sec == 1 ? O_PK : O_PV) + (size_t)row * DM + col : out + (sec == 1 ? O_SK : O_SV) + (size_t)(row - MP) * DM + col;
                        *(f32x4*)o = v0; *(f32x4*)(o + 4) = v1; }
                    else if (col < NH) { float* o = (row < MP) ? out + O_PLF + (size_t)row * NH + col : out + O_SLF + (size_t)(row - MP) * NH + col;
                        float r[8] = {v0[0], v0[1], v0[2], v0[3], v1[0], v1[1], v1[2], v1[3]};
#pragma unroll
                        for (int e = 0; e < 8; ++e) { const float x = r[e] + bfv[col + e]; r[e] = fminf(x, 0.f) - log1pf(__expf(-fabsf(x))); }
                        *(f32x4*)o = (f32x4){r[0], r[1], r[2], r[3]}; *(f32x4*)(o + 4) = (f32x4){r[4], r[5], r[6], r[7]}; } } }
    }
};

__host__ __device__ __forceinline__ int up_pos(int f) { const int n = f >= DFF ? 1 : 0, ch = f - n * DFF; return 256 * (ch >> 7) + 128 * ((ch >> 6) & 1) + 32 * ((ch >> 4) & 3) + 8 * ((ch >> 2) & 3) + 4 * n + (ch & 3); }
template <int CTRL> __device__ __forceinline__ float dpp_(float old, float src) { return __int_as_float(__builtin_amdgcn_update_dpp(__float_as_int(old), __float_as_int(src), CTRL, 0xf, 0xf, false)); }
struct EpiUpF {
    static constexpr bool PERM = true, AFTER_DRAIN = false;
    const float* ssq; bf16_t* g; float* edge; const float* cw; const float* cb;
    __device__ __forceinline__ void operator()(f32x4 (&ac)[2][2][4][2], const Unit& u, int wr, int wc, int fr, int fq) const {
        float rsv[2][4];
#pragma unroll
        for (int ai = 0; ai < 2; ++ai)
#pragma unroll
            for (int mm = 0; mm < 4; ++mm) rsv[ai][mm] = row_rs(ssq, u.pm * 256 + ai * 128 + wr * 64 + mm * 16 + fr);
        f32x4 wq[2][4], wn[2][4];
#define LDW(dst, bjx) do { const int chx_ = 128 * u.pn + 64 * (bjx) + 16 * wc + 4 * fq; _Pragma("unroll") for (int hv_ = 0; hv_ < 2; ++hv_) { dst[hv_][0] = *(const f32x4*)(cw + (unsigned)(hv_ * DFF + chx_)); dst[hv_][1] = *(const f32x4*)(cw + (unsigned)(NUP + hv_ * DFF + chx_)); dst[hv_][2] = *(const f32x4*)(cw + (unsigned)(2 * NUP + hv_ * DFF + chx_)); dst[hv_][3] = *(const f32x4*)(cb + (unsigned)(hv_ * DFF + chx_)); } } while (0)
        LDW(wq, 0);
#pragma unroll
        for (int bj = 0; bj < 2; ++bj) { const int ch0 = 128 * u.pn + 64 * bj + 16 * wc + 4 * fq;
#pragma unroll
            for (int ai = 0; ai < 2; ++ai) { if (bj == 0 && ai == 1) { asm volatile("" ::: "memory"); LDW(wn, 1); }
                if (bj == 1 && ai == 0) {
#pragma unroll
                    for (int hv_ = 0; hv_ < 2; ++hv_)
#pragma unroll
                        for (int t_ = 0; t_ < 4; ++t_) wq[hv_][t_] = wn[hv_][t_]; }
                const int blk = u.pm * 4 + ai * 2 + wr; const int rowb = u.pm * 256 + ai * 128 + wr * 64 + fr;
#pragma unroll
                for (int mm = 0; mm < 4; ++mm) { ac[ai][bj][mm][0] *= rsv[ai][mm]; ac[ai][bj][mm][1] *= rsv[ai][mm]; }
                if (fr < 2 || fr >= 14) { float* ep = edge + (unsigned)((blk * 4 + ((fr + 2) & 3)) * NUP + 2 * ch0); const bool lo_ = fr < 2;
                    f32x4 s0, s1;
#pragma unroll
                    for (int e = 0; e < 4; ++e) { s0[e] = lo_ ? ac[ai][bj][0][0][e] : ac[ai][bj][3][0][e]; s1[e] = lo_ ? ac[ai][bj][0][1][e] : ac[ai][bj][3][1][e]; }
                    *(f32x4*)ep = s0; *(f32x4*)(ep + 4) = s1; }
#pragma unroll
                for (int hv = 0; hv < 2; ++hv)
#pragma unroll
                    for (int e = 0; e < 4; ++e) { const float w0 = wq[hv][0][e], w1 = wq[hv][1][e], w2 = wq[hv][2][e], bq = wq[hv][3][e];
#pragma unroll
                        for (int mm = 3; mm >= 0; --mm) { const float uc = ac[ai][bj][mm][hv][e]; const float pc = mm > 0 ? ac[ai][bj][mm > 0 ? mm - 1 : 0][hv][e] : 0.f;
                            const float q1 = dpp_<0x111>(dpp_<0x121>(0.f, pc), uc), q2 = dpp_<0x112>(dpp_<0x122>(0.f, pc), uc);
                            const float cc_ = bq + w0 * q2 + w1 * q1 + w2 * uc;
                            ac[ai][bj][mm][hv][e] = hv == 0 ? silu(cc_) : cc_; } }
#pragma unroll
                for (int mm = 0; mm < 4; ++mm) if (mm > 0 || fr >= 2) { const f32x4 go = ac[ai][bj][mm][0] * ac[ai][bj][mm][1]; *(u32x2*)(g + (unsigned)((rowb + 16 * mm) * DFF + ch0)) = (u32x2){pk2(go[0], go[1]), pk2(go[2], go[3])}; } } }
    }
};
typedef unsigned v4u __attribute__((ext_vector_type(4)));
#define XB_TMO      128
#define XB_XCNT(j)  (256  + 64 * (j))
#define XB_XSUB(j)  (1280 + 64 * (j))
#define XB_XGEN(j)  (2304 + 64 * (j))
#define XB_TOP      3328
#define XB_TOPGEN   3392
#define XCD_BAR_WORDS 3456
#define XB_SPIN_CAP (1u << 18)

__device__ __forceinline__ unsigned xb_ld(unsigned* p)              { return __hip_atomic_load(p, __ATOMIC_RELAXED, __HIP_MEMORY_SCOPE_AGENT); }
__device__ __forceinline__ unsigned xb_add(unsigned* p, unsigned v) { return __hip_atomic_fetch_add(p, v, __ATOMIC_RELAXED, __HIP_MEMORY_SCOPE_AGENT); }
__device__ __forceinline__ unsigned xb_xcc_id() { return (unsigned)__builtin_amdgcn_s_getreg((3 << 11) | 20) & 0xFu; }
#define XB_SPIN(cond, bar) do { unsigned _sp = 0; while (cond) { __builtin_amdgcn_s_sleep(1); \
    if ((++_sp & 255u) == 0u) { if (xb_ld(&(bar)[XB_TMO])) break; if (_sp > XB_SPIN_CAP) { atomicAdd(&(bar)[XB_TMO], 1u); break; } } } } while (0)

struct XcdBarrier {
    unsigned* bar; unsigned x;
    volatile LAS unsigned* st;
};

__device__ __forceinline__ XcdBarrier xcd_barrier_post(unsigned* bar, volatile LAS unsigned* st) {
    XcdBarrier b; b.bar = bar; b.x = xb_xcc_id(); b.st = st;
    if (threadIdx.x == 0) (void)xb_add(&bar[XB_XCNT(b.x)], 1u);
    return b;
}
__device__ __forceinline__ void xcd_barrier_complete(unsigned* bar, unsigned x, unsigned& nloc, unsigned& nx) {
    const unsigned G = gridDim.x * gridDim.y * gridDim.z;
    unsigned sum, cnt, mine, sp = 0u;
    for (;;) {
        sum = 0u; cnt = 0u; mine = 0u;
#pragma unroll
        for (unsigned j = 0; j < 16; ++j) { const unsigned c = xb_ld(&bar[XB_XCNT(j)]); sum += c; cnt += (c > 0u) ? 1u : 0u; mine = (j == x) ? c : mine; }
        if (sum == G) break;
        __builtin_amdgcn_s_sleep(1);
        if ((++sp & 255u) == 0u) { if (xb_ld(&bar[XB_TMO])) break; if (sp > XB_SPIN_CAP) { atomicAdd(&bar[XB_TMO], 1u); break; } }
    }
    nloc = mine > 0u ? mine : 1u; nx = cnt > 0u ? cnt : 1u;
}

__device__ __forceinline__ void xcd_barrier(const XcdBarrier& b) {
    asm volatile("s_waitcnt vmcnt(0)" ::: "memory");
    __syncthreads();
    if (threadIdx.x == 0) {
        unsigned* bar = b.bar;
        __builtin_amdgcn_s_waitcnt(0);
        unsigned nloc = b.st[0], nx = b.st[1];
        if (nloc == 0u) { xcd_barrier_complete(bar, b.x, nloc, nx); b.st[0] = nloc; b.st[1] = nx; }
        const unsigned old = xb_add(&bar[XB_XSUB(b.x)], 1u);
        const unsigned gen = old / nloc;
        if (old + 1u == (gen + 1u) * nloc) {
            __builtin_amdgcn_fence(__ATOMIC_RELEASE, "agent");
            asm volatile("s_waitcnt vmcnt(0)" ::: "memory");
            const unsigned og = xb_add(&bar[XB_TOP], 1u);
            const unsigned tg = og / nx;
            if (og + 1u == (tg + 1u) * nx) xb_add(&bar[XB_TOPGEN], 1u);
            else XB_SPIN(xb_ld(&bar[XB_TOPGEN]) == tg, bar);
            __builtin_amdgcn_fence(__ATOMIC_ACQUIRE, "agent");
            xb_add(&bar[XB_XGEN(b.x)], 1u);
            asm volatile("s_waitcnt vmcnt(0)" ::: "memory");
        } else {
            XB_SPIN(xb_ld(&bar[XB_XGEN(b.x)]) == gen, bar);
            __builtin_amdgcn_fence(__ATOMIC_ACQUIRE, "agent");
            asm volatile("s_waitcnt vmcnt(0)" ::: "memory");
        }
    }
    __syncthreads();
}
struct Ctx { LAS unsigned char* lds; int tid, lane, wave, G, bid; const float* const* in; float* out; unsigned char* ws; };

template <bool UPPERM = false> __device__ __forceinline__ void p0_transpose_item(const float* W, const float* nw, int K, int N, bf16_t* WT, int row_off, LAS float* scr, int item, int lane) {
    const int nblk = N / 32, kb = item / nblk, nb = item % nblk, k0 = 64 * kb, n0 = 32 * nb;
    float wv[32];
#pragma unroll
    for (int i = 0; i < 32; ++i) { const int kk = 2 * i + (lane >> 5); wv[i] = W[(size_t)(k0 + kk) * N + n0 + (lane & 31)]; }
#pragma unroll
    for (int i = 0; i < 32; ++i) { const int kk = 2 * i + (lane >> 5); const float s = nw ? nw[k0 + kk] : 1.f; scr[kk * 33 + (lane & 31)] = wv[i] * s; }
    asm volatile("s_waitcnt lgkmcnt(0)" ::: "memory");
    const int c = lane & 7;
#pragma unroll
    for (int j = 0; j < 4; ++j) { const int n = (lane >> 3) + 8 * j; const LAS float* s = scr + (8 * c) * 33 + n;
        u32x4 o; o.x = pk2(s[0 * 33], s[1 * 33]); o.y = pk2(s[2 * 33], s[3 * 33]); o.z = pk2(s[4 * 33], s[5 * 33]); o.w = pk2(s[6 * 33], s[7 * 33]);
        const int drow = UPPERM ? up_pos(n0 + n) : row_off + n0 + n;
        *(u32x4*)(WT + (size_t)drow * K + k0 + 8 * c) = o; }
    asm volatile("s_waitcnt lgkmcnt(0)" ::: "memory");
}
constexpr int I_IN = (DM / 64) * (NIN / 32), I_OUT = (DI / 64) * (DM / 32), I_UP = (DM / 64) * (NUP / 32), I_DN = (DFF / 64) * (DM / 32), I_SQ = (DM / 64) * (DM / 32);
constexpr int IT_OUT = I_IN, IT_UP0 = IT_OUT + I_OUT, IT_UP1 = IT_UP0 + I_UP, IT_DN0 = IT_UP1 + I_UP, IT_DN1 = IT_DN0 + I_DN, IT_Q = IT_DN1 + I_DN, IT_K = IT_Q + I_SQ, IT_V = IT_K + I_SQ, IT_O = IT_V + I_SQ, IT_END = IT_O + I_SQ;
__device__ __forceinline__ void convert_items(const Ctx& C, int vi, int vn, int lo, int hi) {
    if (vi < 0) return;
    LAS float* scr = (LAS float*)(C.lds + C.wave * 16384);
    unsigned char* ws = C.ws;
    bf16_t* Win = (bf16_t*)(ws + WS_WIN); bf16_t* Wout = (bf16_t*)(ws + WS_WOUT); bf16_t* Wup = (bf16_t*)(ws + WS_WUP); bf16_t* Wdn = (bf16_t*)(ws + WS_WDN);
    bf16_t* Wq = (bf16_t*)(ws + WS_WQ); bf16_t* Wo = (bf16_t*)(ws + WS_WO);
    for (int it = lo + vi * NW_ + C.wave; it < hi; it += vn * NW_) {
        int r = it;
        if (r < I_IN) { p0_transpose_item(C.in[10], C.in[8], DM, NIN, Win, 0, scr, r, C.lane); continue; } r -= I_IN;
        if (r < I_OUT) { p0_transpose_item(C.in[17], nullptr, DI, DM, Wout, 0, scr, r, C.lane); continue; } r -= I_OUT;
        if (r < I_UP) { p0_transpose_item<true>(C.in[25], C.in[9], DM, NUP, Wup, 0, scr, r, C.lane); continue; } r -= I_UP;
        if (r < I_UP) { p0_transpose_item<true>(C.in[25] + (size_t)DM * NUP, C.in[9] + DM, DM, NUP, Wup + (size_t)NUP * DM, 0, scr, r, C.lane); continue; } r -= I_UP;
        if (r < I_DN) { p0_transpose_item(C.in[28], nullptr, DFF, DM, Wdn, 0, scr, r, C.lane); continue; } r -= I_DN;
        if (r < I_DN) { p0_transpose_item(C.in[28] + (size_t)DFF * DM, nullptr, DFF, DM, Wdn + (size_t)DM * DFF, 0, scr, r, C.lane); continue; } r -= I_DN;
        if (r < I_SQ) { p0_transpose_item(C.in[23], C.in[8] + DM, DM, DM, Wq, 0, scr, r, C.lane); continue; } r -= I_SQ;
        if (r < I_SQ) { p0_transpose_item(C.in[19], C.in[18], DM, DM, Wq, DM, scr, r, C.lane); continue; } r -= I_SQ;
        if (r < I_SQ) { p0_transpose_item(C.in[20], C.in[18], DM, DM, Wq, 2 * DM, scr, r, C.lane); continue; } r -= I_SQ;
        p0_transpose_item(C.in[24], nullptr, DM, DM, Wo, 0, scr, r, C.lane);
    }
}
__device__ __forceinline__ void idle_vgrid(const Ctx& C, int nunits, int& vi, int& vn) { const int ex = nunits % C.G; if (ex == 0) { vi = C.bid; vn = C.G; } else { vn = C.G - ex; vi = C.bid >= ex ? C.bid - ex : -1; } }
__device__ __forceinline__ void phase_prologue(const Ctx& C) {
    const int gw = C.bid * NW_ + C.wave, NGW = C.G * NW_;
    unsigned char* ws = C.ws;
    bf16_t* Win = (bf16_t*)(ws + WS_WIN); bf16_t* Wq = (bf16_t*)(ws + WS_WQ);
    convert_items(C, C.bid, C.G, 0, IT_UP0);
    const int gt = C.bid * NT_ + C.tid, NGT = C.G * NT_;
    for (int i = gt; i < 16 * DM; i += NGT) { const int n = i / DM, k = i % DM; Wq[(size_t)(3 * DM + n) * DM + k] = (bf16_t)f2bf(C.in[21][(size_t)k * 16 + n] * C.in[18][k]); }
    for (int i = gt; i < (NQ - 3 * DM - 16) * DM / 8; i += NGT) ((u32x4*)(Wq + (size_t)(3 * DM + 16) * DM))[i] = (u32x4){0u, 0u, 0u, 0u};
    for (int i = gt; i < (NIN_PAD - NIN) * DM / 8; i += NGT) ((u32x4*)(Win + (size_t)NIN * DM))[i] = (u32x4){0u, 0u, 0u, 0u};
    for (int i = gt; i < 3 * M; i += NGT) ((float*)(ws + WS_SSQ))[M + i] = 0.f;
    float* ssq0 = (float*)(ws + WS_SSQ); bf16_t* hb = (bf16_t*)(ws + WS_HB);
    for (int m0 = gw * 4; m0 < M; m0 += NGW * 4) {
        f32x4 v[4][4];
#pragma unroll
        for (int r = 0; r < 4; ++r) { const int m = m0 + r; const float* xr = (m < MP) ? C.in[0] + (size_t)m * DM : C.in[1] + (size_t)(m - MP) * DM;
#pragma unroll
            for (int j = 0; j < 4; ++j) v[r][j] = ((const f32x4*)xr)[C.lane + 64 * j]; }
#pragma unroll
        for (int r = 0; r < 4; ++r) { const int m = m0 + r; float s = 0.f;
#pragma unroll
            for (int j = 0; j < 4; ++j) { const f32x4 x = v[r][j]; s += (x.x * x.x + x.y * x.y) + (x.z * x.z + x.w * x.w);
                ((u32x2*)(hb + (size_t)m * DM))[C.lane + 64 * j] = (u32x2){pk2(x.x, x.y), pk2(x.z, x.w)}; }
            s = wave_sum(s);
            if (C.lane == 0) ssq0[m] = s; }
    }
}

__device__ __forceinline__ void phase_mconv(const Ctx& C) {
    const bf16_t* x1 = (const bf16_t*)(C.ws + WS_X1); bf16_t* x2 = (bf16_t*)(C.ws + WS_X2); float* dt = (float*)(C.ws + WS_DT);
    const float* cw = C.in[11]; const float* cbias = C.in[12]; const float* st = C.in[3];
    const int gt = C.bid * NT_ + C.tid, NGT = C.G * NT_;
    constexpr int NCG = CONVD / 8, NRB = M / 16;
    for (int it = gt; it < NRB * NCG; it += NGT) {
        const int rb = it / NCG, c0 = (it % NCG) * 8, m0 = rb * 16;
        float w[4][8], bb[8], h0[8], h1[8], h2[8];
#pragma unroll
        for (int t = 0; t < 4; ++t) { const f32x4 a = *(const f32x4*)(cw + t * CONVD + c0), b = *(const f32x4*)(cw + t * CONVD + c0 + 4); w[t][0] = a.x; w[t][1] = a.y; w[t][2] = a.z; w[t][3] = a.w; w[t][4] = b.x; w[t][5] = b.y; w[t][6] = b.z; w[t][7] = b.w; }
        { const f32x4 a = *(const f32x4*)(cbias + c0), b = *(const f32x4*)(cbias + c0 + 4); bb[0] = a.x; bb[1] = a.y; bb[2] = a.z; bb[3] = a.w; bb[4] = b.x; bb[5] = b.y; bb[6] = b.z; bb[7] = b.w; }
        if (rb >= MP / 16) { const float* sp = st + (size_t)(rb - MP / 16) * 3 * CONVD + c0;
#pragma unroll
            for (int e = 0; e < 8; ++e) { h0[e] = sp[e]; h1[e] = sp[CONVD + e]; h2[e] = sp[2 * CONVD + e]; } }
        else if (rb == 0) {
#pragma unroll
            for (int e = 0; e < 8; ++e) { h0[e] = 0.f; h1[e] = 0.f; h2[e] = 0.f; } }
        else { unpack8(*(const u32x4*)(x1 + (size_t)(m0 - 3) * CONVD + c0), h0); unpack8(*(const u32x4*)(x1 + (size_t)(m0 - 2) * CONVD + c0), h1); unpack8(*(const u32x4*)(x1 + (size_t)(m0 - 1) * CONVD + c0), h2); }
        u32x4 rawv[16];
#pragma unroll
        for (int i = 0; i < 16; ++i) rawv[i] = *(const u32x4*)(x1 + (size_t)(m0 + i) * CONVD + c0);
#pragma unroll
        for (int i = 0; i < 16; ++i) { float cur[8], o[8]; unpack8(rawv[i], cur);
#pragma unroll
            for (int e = 0; e < 8; ++e) { const float v = bb[e] + w[0][e] * h0[e] + w[1][e] * h1[e] + w[2][e] * h2[e] + w[3][e] * cur[e]; o[e] = silu(v); h0[e] = h1[e]; h1[e] = h2[e]; h2[e] = cur[e]; }
            *(u32x4*)(x2 + (size_t)(m0 + i) * CONVD + c0) = pack8(o); }
    }
    const float* dtb = C.in[13];
    for (int i = gt; i < M * 32; i += NGT) { const float x = dt[i] + dtb[i & 31]; dt[i] = x > 20.f ? x : log1pf(__expf(x)); }
    for (int i = gt; i < 33 * 3 * CONVD; i += NGT) { const int sq = i / (3 * CONVD), r = i % (3 * CONVD), j = r / CONVD, c = r % CONVD;
        if (sq == 0) C.out[O_PMC + r] = bf1(x1[(size_t)(MP - 3 + j) * CONVD + c]);
        else C.out[O_SMC + (size_t)(sq - 1) * 3 * CONVD + r] = bf1(x1[(size_t)(MP + (sq - 1) * 16 + 13 + j) * CONVD + c]); }
}

__device__ __forceinline__ void phase_fconv(const Ctx& C, int layer) {
    const float* edge = (const float*)(C.ws + WS_EDGE); const bf16_t* up = (const bf16_t*)(C.ws + WS_UPS) - (size_t)MP * NUP; bf16_t* g = (bf16_t*)(C.ws + WS_G);
    const float* cw = C.in[26] + (size_t)layer * 3 * NUP; const float* cbias = C.in[27] + (size_t)layer * NUP; const float* st = C.in[4] + (size_t)layer * NSB * 2 * NUP;
    const int gt = C.bid * NT_ + C.tid, NGT = C.G * NT_;
    constexpr int NC4 = DFF / 4;
    for (int it = gt; it < NCH * 2 * NC4; it += NGT) { const int ch0 = (it % NC4) * 4, br = it / NC4, blk = br >> 1, r = br & 1, pos = up_pos(ch0);
        f32x4 ug, uvl, p1g, p1v, p2g, p2v; const f32x4 z4 = {0.f, 0.f, 0.f, 0.f};
        { const float* e = edge + ((size_t)blk * 4 + 2 + r) * NUP + pos; ug = *(const f32x4*)e; uvl = *(const f32x4*)(e + 4); }
        if (r == 1) { const float* e = edge + ((size_t)blk * 4 + 2) * NUP + pos; p1g = *(const f32x4*)e; p1v = *(const f32x4*)(e + 4); }
        else if (blk > 0) { const float* e = edge + ((size_t)(blk - 1) * 4 + 1) * NUP + pos; p1g = *(const f32x4*)e; p1v = *(const f32x4*)(e + 4); } else { p1g = z4; p1v = z4; }
        if (blk > 0) { const float* e = edge + ((size_t)(blk - 1) * 4 + r) * NUP + pos; p2g = *(const f32x4*)e; p2v = *(const f32x4*)(e + 4); } else { p2g = z4; p2v = z4; }
        const f32x4 w0g = *(const f32x4*)(cw + ch0), w1g = *(const f32x4*)(cw + NUP + ch0), w2g = *(const f32x4*)(cw + 2 * NUP + ch0), bg = *(const f32x4*)(cbias + ch0);
        const f32x4 w0v = *(const f32x4*)(cw + DFF + ch0), w1v = *(const f32x4*)(cw + NUP + DFF + ch0), w2v = *(const f32x4*)(cw + 2 * NUP + DFF + ch0), bv = *(const f32x4*)(cbias + DFF + ch0);
        const f32x4 cg_ = bg + w0g * p2g + w1g * p1g + w2g * ug, cv_ = bv + w0v * p2v + w1v * p1v + w2v * uvl;
        *(u32x2*)(g + (size_t)(64 * blk + r) * DFF + ch0) = (u32x2){pk2(silu(cg_.x) * cv_.x, silu(cg_.y) * cv_.y), pk2(silu(cg_.z) * cv_.z, silu(cg_.w) * cv_.w)}; }
    constexpr int NCG = DFF / 8;
    for (int it = gt; it < (MS / 8) * NCG; it += NGT) {
        const int rb = MP / 8 + it / NCG, c0 = (it % NCG) * 8, m0 = rb * 8;
        const bool sstart = (((m0 - MP) & 15) == 0);
        float o[8][8];
#pragma unroll
        for (int half = 0; half < 2; ++half) {
            const int cc = c0 + half * DFF;
            float w[3][8], bb[8], h0[8], h1[8];
#pragma unroll
            for (int t = 0; t < 3; ++t) { const f32x4 a = *(const f32x4*)(cw + t * NUP + cc), b = *(const f32x4*)(cw + t * NUP + cc + 4); w[t][0] = a.x; w[t][1] = a.y; w[t][2] = a.z; w[t][3] = a.w; w[t][4] = b.x; w[t][5] = b.y; w[t][6] = b.z; w[t][7] = b.w; }
            { const f32x4 a = *(const f32x4*)(cbias + cc), b = *(const f32x4*)(cbias + cc + 4); bb[0] = a.x; bb[1] = a.y; bb[2] = a.z; bb[3] = a.w; bb[4] = b.x; bb[5] = b.y; bb[6] = b.z; bb[7] = b.w; }
            if (sstart) { const float* sp = st + (size_t)((m0 - MP) >> 4) * 2 * NUP + cc;
#pragma unroll
                for (int e = 0; e < 8; ++e) { h0[e] = sp[e]; h1[e] = sp[NUP + e]; } }
            const int pp = up_pos(cc);
#define LD8P(dst, rowp) do { const u32x2 lo_ = *(const u32x2*)((rowp) + pp), hi_ = *(const u32x2*)((rowp) + pp + 8); unpack8((u32x4){lo_.x, lo_.y, hi_.x, hi_.y}, dst); } while (0)
            if (!sstart) { LD8P(h0, up + (size_t)(m0 - 2) * NUP); LD8P(h1, up + (size_t)(m0 - 1) * NUP); }
#pragma unroll
            for (int i = 0; i < 8; ++i) { float cur[8]; LD8P(cur, up + (size_t)(m0 + i) * NUP);
#pragma unroll
                for (int e = 0; e < 8; ++e) { const float v = bb[e] + w[0][e] * h0[e] + w[1][e] * h1[e] + w[2][e] * cur[e]; o[i][e] = half == 0 ? silu(v) : o[i][e] * v; h0[e] = h1[e]; h1[e] = cur[e]; } }
        }
#pragma unroll
        for (int i = 0; i < 8; ++i) *(u32x4*)(g + (size_t)(m0 + i) * DFF + c0) = pack8(o[i]);
    }
    for (int i = gt; i < 33 * 2 * NUP; i += NGT) { const int sq = i / (2 * NUP), r = i % (2 * NUP), j = r / NUP, c = r % NUP;
        if (sq == 0) C.out[O_PFC + (size_t)layer * 2 * NUP + r] = edge[((size_t)(NCH - 1) * 4 + j) * NUP + up_pos(c)];
        else C.out[O_SFC + ((size_t)layer * NSB + (sq - 1)) * 2 * NUP + r] = bf1(up[(size_t)(MP + (sq - 1) * 16 + 14 + j) * NUP + up_pos(c)]); }
#undef LD8P
}

__device__ __forceinline__ void phase_final(const Ctx& C) {
    const int gw = C.bid * NW_ + C.wave, NGW = C.G * NW_; const float* fw = C.in[29]; const bf16_t* hb = (const bf16_t*)(C.ws + WS_HB);
    for (int m0 = gw * 4; m0 < M; m0 += NGW * 4) { u32x4 v[4][2];
#pragma unroll
        for (int r = 0; r < 4; ++r)
#pragma unroll
            for (int j = 0; j < 2; ++j) v[r][j] = ((const u32x4*)(hb + (size_t)(m0 + r) * DM))[C.lane + 64 * j];
#pragma unroll
        for (int r = 0; r < 4; ++r) { float f[2][8]; float s = 0.f;
#pragma unroll
            for (int j = 0; j < 2; ++j) { unpack8(v[r][j], f[j]);
#pragma unroll
                for (int e = 0; e < 8; ++e) s += f[j][e] * f[j][e]; }
            const float rs = rsqrtf(wave_sum(s) * (1.f / DM) + EPS);
#pragma unroll
            for (int j = 0; j < 2; ++j) { const int c0 = 8 * (C.lane + 64 * j); const f32x4 w0 = *(const f32x4*)(fw + c0), w1 = *(const f32x4*)(fw + c0 + 4); float* o = C.out + (size_t)(m0 + r) * DM + c0;
                *(f32x4*)o = (f32x4){f[j][0] * rs * w0.x, f[j][1] * rs * w0.y, f[j][2] * rs * w0.z, f[j][3] * rs * w0.w}; *(f32x4*)(o + 4) = (f32x4){f[j][4] * rs * w1.x, f[j][5] * rs * w1.y, f[j][6] * rs * w1.z, f[j][7] * rs * w1.w}; } }
    }
}
typedef short v4i16_t __attribute__((ext_vector_type(4)));
__device__ __forceinline__ s16x4 vtr(const LAS unsigned char* p) { return __builtin_bit_cast(s16x4, __builtin_amdgcn_ds_read_tr16_b64_v4i16((LAS v4i16_t*)p)); }
__device__ __forceinline__ bf16x8 trfrag(const LAS unsigned char* img, int rs, int k0, int c0, int lane) {
    const int gq = lane >> 4, li = lane & 15, q = li >> 2, p = li & 3;
    const LAS unsigned char* a = img + (k0 + 8 * gq + q) * rs + (c0 + 4 * p) * 2;
    const s16x4 r1 = vtr(a), r2 = vtr(a + 4 * rs);
    return (bf16x8){r1[0], r1[1], r1[2], r1[3], r2[0], r2[1], r2[2], r2[3]};
}
constexpr int RSB = 272, RSX = 144;
constexpr int SSD_UNITS = (NCH + NSB) * 4;
__device__ __forceinline__ void ssd_unit_geom(int unit, int& uc, int& g, int& m0, int& L) { uc = unit >> 2; g = unit & 3; if (uc < NCH) { m0 = 64 * uc; L = 64; } else { m0 = MP + 16 * (uc - NCH); L = 16; } }
__device__ __forceinline__ void ssd_load_tile128(const Ctx& C, LAS unsigned char* dst, const bf16_t* x2, int m0, int L, int col0) {
    const int row = C.tid >> 3;
#pragma unroll
    for (int cc = 0; cc < 2; ++cc) { const int ch = (C.tid & 7) * 2 + cc; u32x4 v = {0u, 0u, 0u, 0u};
        if (row < L) v = *(const u32x4*)(x2 + (size_t)(m0 + row) * CONVD + col0 + 8 * ch);
        *(LAS u32x4*)(dst + row * RSB + 16 * ch) = v; }
}

__device__ __forceinline__ void phase_ssd1(const Ctx& C, int unit_lo, int unit_hi) {
    const bf16_t* x2 = (const bf16_t*)(C.ws + WS_X2); const float* dt = (const float*)(C.ws + WS_DT); bf16_t* st = (bf16_t*)(C.ws + WS_ST); float* dec = (float*)(C.ws + WS_DEC);
    LAS unsigned char* Bs = C.lds; LAS unsigned char* Xs = C.lds + 17408 + C.wave * 13824; LAS float* sc = (LAS float*)(Xs + 9216); LAS unsigned char* stg = Xs + 9472;
    const int lane = C.lane, gq = lane >> 4, li = lane & 15;
    for (int unit = unit_lo + C.bid; unit < unit_hi; unit += C.G) {
        int uc, g, m0, L; ssd_unit_geom(unit, uc, g, m0, L);
        const int h = 8 * g + C.wave;
        ssd_load_tile128(C, Bs, x2, m0, L, DI + 128 * g);
        const float Ah = -__expf(C.in[14][h]);
        const float dtv = (lane < L) ? dt[(size_t)(m0 + lane) * 32 + h] : 0.f;
        u32x4 xr[8];
#pragma unroll
        for (int i = 0; i < 8; ++i) { const int srow = 8 * i + (lane >> 3), pc = lane & 7; xr[i] = (u32x4){0u, 0u, 0u, 0u};
            if (srow < L) xr[i] = *(const u32x4*)(x2 + (size_t)(m0 + srow) * CONVD + 64 * h + 8 * pc); }
        int ls_ = lane; asm volatile("" : "+v"(ls_)); const float acum = wave_incl_scan(dtv * Ah, ls_); const float last = __shfl(acum, 63);
        sc[lane] = dtv * __expf(last - acum);
        asm volatile("s_waitcnt lgkmcnt(0)" ::: "memory");
#pragma unroll
        for (int i = 0; i < 8; ++i) { const int srow = 8 * i + (lane >> 3), pc = lane & 7;
            float f[8]; unpack8(xr[i], f); const float s = sc[srow];
#pragma unroll
            for (int e = 0; e < 8; ++e) f[e] *= s;
            *(LAS u32x4*)(Xs + srow * RSX + 16 * pc) = pack8(f); }
        __syncthreads();
        const float elast = __expf(last);
#pragma unroll 1
        for (int pt = 0; pt < 4; ++pt) {
            const bf16x8 xf0 = trfrag(Xs, RSX, 0, 16 * pt, lane), xf1 = trfrag(Xs, RSX, 32, 16 * pt, lane);
            f32x4 acc[8];
#pragma unroll
            for (int nt = 0; nt < 8; ++nt) { acc[nt] = (f32x4){0.f, 0.f, 0.f, 0.f};
                const bf16x8 af0 = trfrag(Bs, RSB, 0, 16 * nt, lane), af1 = trfrag(Bs, RSB, 32, 16 * nt, lane);
                acc[nt] = __builtin_amdgcn_mfma_f32_16x16x32_bf16(af0, xf0, acc[nt], 0, 0, 0); acc[nt] = __builtin_amdgcn_mfma_f32_16x16x32_bf16(af1, xf1, acc[nt], 0, 0, 0); }
            if (uc < NCH) {
#pragma unroll
                for (int nt = 0; nt < 8; ++nt) *(LAS u32x2*)(stg + li * RSB + 2 * (16 * nt + 4 * gq)) = (u32x2){pk2(acc[nt][0], acc[nt][1]), pk2(acc[nt][2], acc[nt][3])};
                asm volatile("s_waitcnt lgkmcnt(0)" ::: "memory");
#pragma unroll
                for (int i = 0; i < 4; ++i) { const int row = 4 * i + gq; const u32x4 v = *(const LAS u32x4*)(stg + row * RSB + 16 * li);
                    *(u32x4*)(st + ((size_t)(uc * 32 + h) * 64 + 16 * pt + row) * 128 + 8 * li) = v; }
            } else {
#pragma unroll
                for (int nt = 0; nt < 8; ++nt) { const size_t idx = ((size_t)((uc - NCH) * 32 + h) * 64 + 16 * pt + li) * 128 + 16 * nt + 4 * gq; const f32x4 h0 = *(const f32x4*)(C.in[2] + idx); *(f32x4*)(C.out + O_SSSM + idx) = h0 * elast + acc[nt]; }
            }
        }
        if (uc < NCH && lane == 0) dec[uc * 32 + h] = elast;
        __syncthreads();
    }
}

__device__ __forceinline__ void phase_scan(const Ctx& C) {
    unsigned* st = (unsigned*)(C.ws + WS_ST); const float* dec = (const float*)(C.ws + WS_DEC);
    const int gt = C.bid * NT_ + C.tid, NGT = C.G * NT_;
    for (int e2 = gt; e2 < 32 * 8192 / 2; e2 += NGT) { const int h = e2 >> 12; float r0 = 0.f, r1 = 0.f;
        for (int c0 = 0; c0 < NCH; c0 += 32) { unsigned v[32]; float d[32];
#pragma unroll
            for (int i = 0; i < 32; ++i) { v[i] = st[(size_t)(c0 + i) * 131072 + e2]; d[i] = dec[(c0 + i) * 32 + h]; }
#pragma unroll
            for (int i = 0; i < 32; ++i) { st[(size_t)(c0 + i) * 131072 + e2] = pk2(r0, r1); r0 = r0 * d[i] + bflo(v[i]); r1 = r1 * d[i] + bfhi(v[i]); } }
        *(float2*)(C.out + O_PSSM + 2 * (size_t)e2) = make_float2(r0, r1); }
}

__device__ __forceinline__ void phase_ssd3(const Ctx& C, int unit_lo, int unit_hi, int rot) {
    const bf16_t* x2 = (const bf16_t*)(C.ws + WS_X2); const float* dt = (const float*)(C.ws + WS_DT); const bf16_t* st = (const bf16_t*)(C.ws + WS_ST);
    const bf16_t* zb = (const bf16_t*)(C.ws + WS_ZB); bf16_t* yb = (bf16_t*)(C.ws + WS_X1);
    LAS unsigned char* Cs = C.lds; LAS unsigned char* Bs = C.lds + 17408; LAS float* CB = (LAS float*)Bs;
    LAS unsigned char* Xs = C.lds + 34816 + C.wave * 9728; LAS float* ac = (LAS float*)(Xs + 9216); LAS float* ds = ac + 64;
    LAS float* red = (LAS float*)(C.lds + 34816 + 8 * 9728);
    const int lane = C.lane, gq = lane >> 4, li = lane & 15;
    for (int unit = unit_lo + (C.bid + rot) % C.G; unit < unit_hi; unit += C.G) {
        int uc, g, m0, L; ssd_unit_geom(unit, uc, g, m0, L);
        const int h = 8 * g + C.wave;
        ssd_load_tile128(C, Bs, x2, m0, L, DI + 128 * g);
        ssd_load_tile128(C, Cs, x2, m0, L, DI + 512 + 128 * g);
        const float Ah = -__expf(C.in[14][h]);
        const float dtv = (lane < L) ? dt[(size_t)(m0 + lane) * 32 + h] : 0.f;
        int ls_ = lane; asm volatile("" : "+v"(ls_)); const float acum = wave_incl_scan(dtv * Ah, ls_);
        ac[lane] = acum; ds[lane] = dtv;
#pragma unroll
        for (int i = 0; i < 8; ++i) { const int srow = 8 * i + (lane >> 3), pc = lane & 7; u32x4 v = {0u, 0u, 0u, 0u};
            if (srow < L) v = *(const u32x4*)(x2 + (size_t)(m0 + srow) * CONVD + 64 * h + 8 * pc);
            *(LAS u32x4*)(Xs + srow * RSX + 16 * pc) = v; }
        __syncthreads();
        f32x4 accb[2];
#pragma unroll
        for (int i = 0; i < 2; ++i) { const int id = 2 * C.wave + i, tt = id >> 2, sl = id & 3; accb[i] = (f32x4){0.f, 0.f, 0.f, 0.f};
#pragma unroll
            for (int kn = 0; kn < 4; ++kn) { const bf16x8 a = *(const LAS bf16x8*)(Cs + (16 * tt + li) * RSB + (32 * kn + 8 * gq) * 2), b = *(const LAS bf16x8*)(Bs + (16 * sl + li) * RSB + (32 * kn + 8 * gq) * 2);
                accb[i] = __builtin_amdgcn_mfma_f32_16x16x32_bf16(a, b, accb[i], 0, 0, 0); } }
        __syncthreads();
#pragma unroll
        for (int i = 0; i < 2; ++i) { const int id = 2 * C.wave + i, tt = id >> 2, sl = id & 3;
#pragma unroll
            for (int r = 0; r < 4; ++r) CB[(16 * tt + 4 * gq + r) * 68 + 16 * sl + li] = accb[i][r]; }
        __syncthreads();
        f32x4 acc[4][4];
#pragma unroll
        for (int tt = 0; tt < 4; ++tt)
#pragma unroll
            for (int pt = 0; pt < 4; ++pt) acc[tt][pt] = (f32x4){0.f, 0.f, 0.f, 0.f};
#pragma unroll
        for (int pt = 0; pt < 4; ++pt) {
            if (pt == 2) __builtin_amdgcn_sched_barrier(0);
#pragma unroll
            for (int kn = 0; kn < 4; ++kn) { bf16x8 b;
                if (uc < NCH) b = *(const bf16x8*)(st + ((size_t)(uc * 32 + h) * 64 + 16 * pt + li) * 128 + 32 * kn + 8 * gq);
                else { const float* sp = C.in[2] + ((size_t)((uc - NCH) * 32 + h) * 64 + 16 * pt + li) * 128 + 32 * kn + 8 * gq; const f32x4 s0 = *(const f32x4*)sp, s1 = *(const f32x4*)(sp + 4);
                    const u32x4 w = {pk2(s0.x, s0.y), pk2(s0.z, s0.w), pk2(s1.x, s1.y), pk2(s1.z, s1.w)}; b = __builtin_bit_cast(bf16x8, w); }
#pragma unroll
                for (int tt = 0; tt < 4; ++tt) { const bf16x8 a = *(const LAS bf16x8*)(Cs + (16 * tt + li) * RSB + (32 * kn + 8 * gq) * 2); acc[tt][pt] = __builtin_amdgcn_mfma_f32_16x16x32_bf16(a, b, acc[tt][pt], 0, 0, 0); } }
        }
#pragma unroll
        for (int tt = 0; tt < 4; ++tt)
#pragma unroll
            for (int r = 0; r < 4; ++r) { const float e = __expf(ac[16 * tt + 4 * gq + r]);
#pragma unroll
                for (int pt = 0; pt < 4; ++pt) acc[tt][pt][r] *= e; }
        bf16x8 xf[2][4];
#pragma unroll
        for (int ks = 0; ks < 2; ++ks)
#pragma unroll
            for (int pt = 0; pt < 4; ++pt) xf[ks][pt] = trfrag(Xs, RSX, 32 * ks, 16 * pt, lane);
#pragma unroll
        for (int tt = 0; tt < 4; ++tt) { __builtin_amdgcn_sched_barrier(0); const int t = 16 * tt + li; const float at = ac[t];
#pragma unroll
            for (int ks = 0; ks < 2; ++ks) { if (32 * ks > 16 * tt + 15) continue;
                const int s0 = 32 * ks + 8 * gq; float w[8];
                const f32x4 c0 = *(const LAS f32x4*)(CB + t * 68 + s0), c1 = *(const LAS f32x4*)(CB + t * 68 + s0 + 4);
                const f32x4 a0 = *(const LAS f32x4*)(ac + s0), a1 = *(const LAS f32x4*)(ac + s0 + 4), d0 = *(const LAS f32x4*)(ds + s0), d1 = *(const LAS f32x4*)(ds + s0 + 4);
#pragma unroll
                for (int j = 0; j < 4; ++j) { w[j] = (s0 + j <= t) ? c0[j] * __expf(at - a0[j]) * d0[j] : 0.f; w[4 + j] = (s0 + 4 + j <= t) ? c1[j] * __expf(at - a1[j]) * d1[j] : 0.f; }
                const u32x4 wp = pack8(w); const bf16x8 af = __builtin_bit_cast(bf16x8, wp);
#pragma unroll
                for (int pt = 0; pt < 4; ++pt) acc[tt][pt] = __builtin_amdgcn_mfma_f32_16x16x32_bf16(af, xf[ks][pt], acc[tt][pt], 0, 0, 0); } }
        const float Dh = C.in[15][h];
        asm volatile("" ::: "memory"); __builtin_amdgcn_sched_barrier(0);
        u32x4 zr[8];
#pragma unroll
        for (int i = 0; i < 8; ++i) { const int srow = 8 * i + (lane >> 3), pc = lane & 7; zr[i] = (u32x4){0u, 0u, 0u, 0u};
            if (srow < L) zr[i] = *(const u32x4*)(zb + (size_t)(m0 + srow) * DI + 64 * h + 8 * pc); }
        const LAS unsigned char* trb = Xs + (4 * gq + (li >> 2)) * RSX + 8 * (li & 3);
#pragma unroll
        for (int tt = 0; tt < 4; ++tt)
#pragma unroll
            for (int pt = 0; pt < 4; ++pt) { const s16x4 xv = vtr(trb + 16 * tt * RSX + 32 * pt);
#pragma unroll
                for (int r = 0; r < 4; ++r) acc[tt][pt][r] += Dh * bf1((bf16_t)xv[r]); }
        asm volatile("s_waitcnt lgkmcnt(0)" ::: "memory");
#pragma unroll
        for (int i = 0; i < 8; ++i) { const int srow = 8 * i + (lane >> 3), pc = lane & 7; *(LAS u32x4*)(Xs + srow * RSX + 16 * pc) = zr[i]; }
        asm volatile("s_waitcnt lgkmcnt(0)" ::: "memory");
#pragma unroll
        for (int tt = 0; tt < 4; ++tt) { s16x4 zv[4];
#pragma unroll
            for (int pt = 0; pt < 4; ++pt) zv[pt] = vtr(trb + 16 * tt * RSX + 32 * pt);
#pragma unroll
            for (int r = 0; r < 4; ++r) { const int t = 16 * tt + 4 * gq + r; float s = 0.f;
#pragma unroll
                for (int pt = 0; pt < 4; ++pt) { const float z = bf1((bf16_t)zv[pt][r]); const float v = acc[tt][pt][r] * silu(z); acc[tt][pt][r] = v; s += v * v; }
                s += __shfl_xor(s, 1); s += __shfl_xor(s, 2); s += __shfl_xor(s, 4); s += __shfl_xor(s, 8);
                if (li == 0) red[t * 8 + C.wave] = s; } }
        __syncthreads();
        const float* nw = C.in[16];
        float nwv[4];
#pragma unroll
        for (int pt = 0; pt < 4; ++pt) nwv[pt] = nw[64 * h + 16 * pt + li];
#pragma unroll
        for (int tt = 0; tt < 4; ++tt) {
#pragma unroll
            for (int r = 0; r < 4; ++r) { const int t = 16 * tt + 4 * gq + r; const f32x4 q0 = *(const LAS f32x4*)(red + t * 8), q1 = *(const LAS f32x4*)(red + t * 8 + 4);
                const float rs = rsqrtf((((q0.x + q0.y) + (q0.z + q0.w)) + ((q1.x + q1.y) + (q1.z + q1.w))) * (1.f / 512.f) + EPS);
#pragma unroll
                for (int pt = 0; pt < 4; ++pt) *(LAS bf16_t*)(Xs + t * RSX + 2 * (16 * pt + li)) = (bf16_t)f2bf(acc[tt][pt][r] * rs * nwv[pt]); }
            asm volatile("s_waitcnt lgkmcnt(0)" ::: "memory");
#pragma unroll
            for (int i = 0; i < 2; ++i) { const int srow = 16 * tt + 8 * i + (lane >> 3), pc = lane & 7;
                if (srow < L) *(u32x4*)(yb + (size_t)(m0 + srow) * DI + 64 * h + 8 * pc) = *(const LAS u32x4*)(Xs + srow * RSX + 16 * pc); }
            __builtin_amdgcn_sched_barrier(0);
        }
        __syncthreads();
    }
}

__device__ __forceinline__ void phase_cumsum(const Ctx& C) {
    float* cb = (float*)(C.ws + WS_CB); float* cs = (float*)(C.ws + WS_CS); LAS float* wt = (LAS float*)C.lds;
    for (int h = C.bid; h < NH; h += C.G) {
        const float* lf = C.out + O_PLF; float v[32]; float s = 0.f;
#pragma unroll
        for (int i = 0; i < 32; ++i) { v[i] = lf[(size_t)(32 * C.tid + i) * NH + h]; s += v[i]; }
        const float inc = wave_incl_scan(s, C.lane);
        if (C.lane == 63) wt[C.wave] = inc;
        __syncthreads();
        float base = inc - s;
#pragma unroll
        for (int w = 0; w < 8; ++w) if (w < C.wave) base += wt[w];
        float run = base;
#pragma unroll
        for (int i = 0; i < 32; ++i) { run += v[i]; cb[(size_t)h * MP + 32 * C.tid + i] = -run * LOG2E; }
        __syncthreads();
    }
    const int gw = C.bid * NW_ + C.wave, NGW = C.G * NW_;
    for (int idx = gw; idx < NSB * NH; idx += NGW) { const int b = idx >> 4, h = idx & 15; float v[17]; float s = 0.f;
#pragma unroll
        for (int i = 0; i < 17; ++i) { const int k = 17 * C.lane + i; float x = 0.f;
            if (k < PAST) x = C.in[7][((size_t)b * PAST + k) * NH + h]; else if (k < KL) x = C.out[O_SLF + ((size_t)b * SL + (k - PAST)) * NH + h];
            v[i] = x; s += x; }
        float run = wave_incl_scan(s, C.lane) - s;
#pragma unroll
        for (int i = 0; i < 17; ++i) { const int k = 17 * C.lane + i; run += v[i]; if (k < KL) cs[(size_t)idx * KL + k] = -run * LOG2E; } }
}

__device__ __forceinline__ void phase_attn_sample(const Ctx& C) {
    bf16_t* Qb = (bf16_t*)(C.ws + WS_QB); const bf16_t* Kb = (const bf16_t*)(C.ws + WS_KB); const bf16_t* Vb = (const bf16_t*)(C.ws + WS_VB); const float* cs = (const float*)(C.ws + WS_CS);
    LAS float* qs = (LAS float*)C.lds; LAS float* pbuf = (LAS float*)(C.lds + 4096) + C.wave * 1024; LAS float* comb = (LAS float*)(C.lds + 36864); LAS float* ml = (LAS float*)(C.lds + 69632);
    const int lane = C.lane;
    for (int unit = C.bid; unit < NSB * NH; unit += C.G) { const int b = unit >> 4, h = unit & 15;
        for (int i = C.tid; i < 1024; i += NT_) qs[i] = bf1(Qb[(size_t)(MP + 16 * b + (i >> 6)) * DM + 64 * h + (i & 63)]);
        __syncthreads();
        float m[16], l[16], o[16];
#pragma unroll
        for (int q = 0; q < 16; ++q) { m[q] = -1e30f; l[q] = 0.f; o[q] = 0.f; }
        for (int batch = C.wave; batch < 17; batch += 8) {
            const int key = batch * 64 + lane; const bool valid = key < KL; const int kc = valid ? key : KL - 1;
            float s[16];
#pragma unroll
            for (int q = 0; q < 16; ++q) s[q] = 0.f;
            if (batch < PAST / 64) {
                const float* kp = C.in[5] + (((size_t)b * PAST + kc) * NH + h) * 64;
#pragma unroll 4
                for (int dc = 0; dc < 16; ++dc) { const f32x4 kv = ((const f32x4*)kp)[dc];
#pragma unroll
                    for (int q = 0; q < 16; ++q) { const f32x4 qv = *(const LAS f32x4*)(qs + q * 64 + 4 * dc); s[q] += (kv.x * qv.x + kv.y * qv.y) + (kv.z * qv.z + kv.w * qv.w); } }
            } else {
                const bf16_t* kpn = Kb + (unsigned)((MP + b * SL + (kc - PAST)) * DM + 64 * h);
#pragma unroll 4
                for (int dc = 0; dc < 16; ++dc) { const u32x2 kw = ((const u32x2*)kpn)[dc]; const f32x4 kv = {bflo(kw.x), bfhi(kw.x), bflo(kw.y), bfhi(kw.y)};
#pragma unroll
                    for (int q = 0; q < 16; ++q) { const f32x4 qv = *(const LAS f32x4*)(qs + q * 64 + 4 * dc); s[q] += (kv.x * qv.x + kv.y * qv.y) + (kv.z * qv.z + kv.w * qv.w); } }
            }
            const float bias = cs[(size_t)unit * KL + kc];
#pragma unroll
            for (int q = 0; q < 16; ++q) { const bool ok = valid && (kc < PAST || kc - PAST <= q); const float sv = ok ? s[q] + bias : -1e30f;
                const float mn = fmaxf(m[q], wave_max(sv)); const float p = ok ? __builtin_amdgcn_exp2f(sv - mn) : 0.f; const float scl = __builtin_amdgcn_exp2f(m[q] - mn);
                l[q] = l[q] * scl + wave_sum(p); o[q] *= scl; m[q] = mn; pbuf[lane * 16 + q] = p; }
            asm volatile("s_waitcnt lgkmcnt(0)" ::: "memory");
            const int jmax = min(64, KL - batch * 64);
            for (int j0 = 0; j0 < jmax; j0 += 8) { float vv[8];
#pragma unroll
                for (int u = 0; u < 8; ++u) { const int kj = batch * 64 + j0 + u;
                    vv[u] = (kj < PAST) ? C.in[6][(((size_t)b * PAST + kj) * NH + h) * 64 + lane] : bf1(Vb[(unsigned)((MP + b * SL + (kj - PAST)) * DM + 64 * h + lane)]); }
#pragma unroll
                for (int u = 0; u < 8; ++u) {
#pragma unroll
                    for (int q4 = 0; q4 < 4; ++q4) { const f32x4 p4 = *(const LAS f32x4*)(pbuf + (j0 + u) * 16 + 4 * q4); o[4 * q4] += p4.x * vv[u]; o[4 * q4 + 1] += p4.y * vv[u]; o[4 * q4 + 2] += p4.z * vv[u]; o[4 * q4 + 3] += p4.w * vv[u]; } } }
        }
#pragma unroll
        for (int q = 0; q < 16; ++q) { comb[(C.wave * 16 + q) * 64 + lane] = o[q]; if (lane == 0) { ml[C.wave * 32 + q] = m[q]; ml[C.wave * 32 + 16 + q] = l[q]; } }
        __syncthreads();
        for (int i = C.tid; i < 1024; i += NT_) { const int q = i >> 6, d = i & 63; float mm = -1e30f;
#pragma unroll
            for (int w = 0; w < 8; ++w) mm = fmaxf(mm, ml[w * 32 + q]);
            float ll = 0.f, oo = 0.f;
#pragma unroll
            for (int w = 0; w < 8; ++w) { const float f = __builtin_amdgcn_exp2f(ml[w * 32 + q] - mm); ll += ml[w * 32 + 16 + q] * f; oo += comb[(w * 16 + q) * 64 + d] * f; }
            Qb[(size_t)(MP + 16 * b + q) * DM + 64 * h + d] = (bf16_t)f2bf(oo * __builtin_amdgcn_rcpf(ll)); }
        __syncthreads();
    }
}

__device__ __forceinline__ void small_gemm_res(const Ctx& C, const bf16_t* A, const bf16_t* Bt, int K, float* hf, bf16_t* hb, float* ssq, const float* xs) {
    const int lane = C.lane, li = lane & 15, gq = lane >> 4; const int kw = K / 8, nst = kw / 32;
    LAS float* part = (LAS float*)C.lds;
    for (int id = C.bid; id < 256; id += C.G) {
        const int rg = id >> 4, ct = id & 15, row0 = MP + 32 * rg, col0 = 64 * ct;
        const bf16_t* ap = A + (size_t)(row0 + li) * K + C.wave * kw + 8 * gq; const bf16_t* bp = Bt + (size_t)(col0 + li) * K + C.wave * kw + 8 * gq;
        f32x4 acc[2][4];
#pragma unroll
        for (int r2 = 0; r2 < 2; ++r2)
#pragma unroll
            for (int c = 0; c < 4; ++c) acc[r2][c] = (f32x4){0.f, 0.f, 0.f, 0.f};
        for (int s0 = 0; s0 < nst; s0 += 4) { bf16x8 a[4][2], b[4][4];
#pragma unroll
            for (int u = 0; u < 4; ++u) { const int s = min(s0 + u, nst - 1); a[u][0] = *(const bf16x8*)(ap + 32 * s); a[u][1] = *(const bf16x8*)(ap + (size_t)16 * K + 32 * s);
#pragma unroll
                for (int c = 0; c < 4; ++c) b[u][c] = *(const bf16x8*)(bp + (size_t)(16 * c) * K + 32 * s); }
#pragma unroll
            for (int u = 0; u < 4; ++u) if (s0 + u < nst) {
#pragma unroll
                for (int r2 = 0; r2 < 2; ++r2)
#pragma unroll
                    for (int c = 0; c < 4; ++c) acc[r2][c] = __builtin_amdgcn_mfma_f32_16x16x32_bf16(a[u][r2], b[u][c], acc[r2][c], 0, 0, 0); } }
#pragma unroll
        for (int r2 = 0; r2 < 2; ++r2)
#pragma unroll
            for (int c = 0; c < 4; ++c)
#pragma unroll
                for (int r = 0; r < 4; ++r) part[(C.wave * 32 + 16 * r2 + 4 * gq + r) * 64 + 16 * c + li] = acc[r2][c][r];
        __syncthreads();
        { int t2_ = C.tid; asm volatile("" : "+v"(t2_)); const int row = t2_ >> 4, cp = (t2_ & 15) * 4; f32x4 v = {0.f, 0.f, 0.f, 0.f};
#pragma unroll
            for (int w = 0; w < 8; ++w) v += *(const LAS f32x4*)(part + (w * 32 + row) * 64 + cp);
            const size_t idx = (size_t)(row0 + row) * DM + col0 + cp;
            if (xs) v += *(const f32x4*)(xs + idx - (size_t)MP * DM); else { const u32x2 hw = *(const u32x2*)(hb + idx); v += (f32x4){bflo(hw.x), bfhi(hw.x), bflo(hw.y), bfhi(hw.y)}; }
            *(u32x2*)(hb + idx) = (u32x2){pk2(v.x, v.y), pk2(v.z, v.w)};
            float sq = (v.x * v.x + v.y * v.y) + (v.z * v.z + v.w * v.w); sq += __shfl_xor(sq, 1); sq += __shfl_xor(sq, 2); sq += __shfl_xor(sq, 4); sq += __shfl_xor(sq, 8);
            if ((t2_ & 15) == 0) atomicAdd(ssq + row0 + row, sq); }
        __syncthreads();
    }
}

__device__ __forceinline__ void phase_norms(const Ctx& C) {
    const bf16_t* Qb = (const bf16_t*)(C.ws + WS_QB); const bf16_t* Kb = (const bf16_t*)(C.ws + WS_KB); float* nrm = (float*)(C.ws + WS_NRM);
    const bool split = C.G > 2 * NH; if (split && C.bid < NH) return;
    const int gw = (split ? C.bid - NH : C.bid) * NW_ + C.wave, NGW = (split ? C.G - NH : C.G) * NW_;
    for (int task = gw; task < (MP / 64) * NH; task += NGW) { const int tile = task >> 4, h = task & 15; const unsigned off = (unsigned)((tile * 64 + C.lane) * DM + h * 64); float sq = 0.f, sk = 0.f;
#pragma unroll
        for (int c = 0; c < 8; ++c) { float f[8]; unpack8(*(const u32x4*)(Qb + off + 8 * c), f);
#pragma unroll
            for (int e = 0; e < 8; ++e) sq += f[e] * f[e];
            unpack8(*(const u32x4*)(Kb + off + 8 * c), f);
#pragma unroll
            for (int e = 0; e < 8; ++e) sk += f[e] * f[e]; }
        sq = wave_max(sq); sk = wave_max(sk);
        if (C.lane == 0) { nrm[h * 256 + tile] = sqrtf(sq) * 1.001f; nrm[NH * 256 + h * 256 + tile] = sqrtf(sk) * 1.001f; } }
}
struct NoBetween { __device__ __forceinline__ void operator()(int) const {} };
__global__ void __launch_bounds__(NT_, 2) mega_fwd(Args a) {
    __builtin_assume(__builtin_amdgcn_workitem_id_y() == 0); __builtin_assume(__builtin_amdgcn_workitem_id_z() == 0);
    extern __shared__ __attribute__((aligned(16))) unsigned char lds[];
    cg::grid_group grid = cg::this_grid();
    Ctx C; C.lds = (LAS unsigned char*)lds; C.tid = threadIdx.x; C.lane = C.tid & 63; C.wave = __builtin_amdgcn_readfirstlane(C.tid >> 6); C.G = gridDim.x; C.bid = blockIdx.x;
    { const float* const* inp = (const float* const*)__builtin_amdgcn_kernarg_segment_ptr(); asm volatile("" : "+s"(inp)); C.in = inp; }     C.out = a.out; C.ws = a.ws;
    unsigned char* ws = a.ws;
    float* ssq = (float*)(ws + WS_SSQ); constexpr size_t SSQN = (size_t)M;
    bf16_t* hb = (bf16_t*)(ws + WS_HB);
    const int lo = a.ph_lo, hi = a.ph_hi;
    unsigned* barw = (unsigned*)(ws + WS_BAR);
    if (C.tid < 2) ((volatile LAS unsigned*)(C.lds + LDS_TOTAL - 512))[C.tid] = 0u;
    if (C.bid == 0) for (int i = C.tid; i < XCD_BAR_WORDS; i += NT_) barw[i] = 0u;
    XcdBarrier bar; bar.bar = barw; bar.x = 0; bar.st = nullptr;
#ifndef GEMM_ALIGN
#define GEMM_ALIGN true
#endif
#ifndef ATTN_THRL
#define ATTN_THRL 40
#endif
#ifndef REP_MASK
#define REP_MASK 0
#endif
#ifndef EXTRA_SYNCS
#define EXTRA_SYNCS 0
#endif
#define IN(k) (lo <= (k) && (k) < hi)
#define SEAM(k) do { if (IN(k) && IN((k) + 1)) { if ((k) == 0) { grid.sync(); bar = xcd_barrier_post(barw, (volatile LAS unsigned*)(C.lds + LDS_TOTAL - 512)); } else xcd_barrier(bar); } } while (0)
#define GEMMM(EPI, E, Aop, Bop, M_, N_, K_) do { pg8::Gemm g_{(const bf16_t*)(Aop), (const bf16_t*)(Bop), (M_), (N_), (K_)}; pg8::StaticOrder S_; S_.init((M_), (N_), C.G, C.bid); \
        pg8::gemm_phase<EPI, pg8::StaticOrder, GEMM_ALIGN, true>(C.lds, g_, S_, E); __syncthreads(); } while (0)

#define GEMM(EPI, E, Aop, Bop, N_, K_) GEMMM(EPI, E, Aop, Bop, M, N_, K_)
#define GEMMS(EPI, E, Aop, Bop, N_, K_) do { pg8::Gemm g_{(const bf16_t*)(Aop), (const bf16_t*)(Bop), MS, (N_), (K_)}; pg8::StaticOrder S_; S_.init(MS, (N_), C.G, C.G - 1 - C.bid); \
        pg8::gemm_phase<EPI, pg8::StaticOrder, GEMM_ALIGN, true>(C.lds, g_, S_, E); __syncthreads(); } while (0)
#define GEMMR(E, Aop, Bop, K_) do { GEMMM(EpiRes, E, Aop, Bop, MP, DM, K_); small_gemm_res(C, (const bf16_t*)(Aop), (const bf16_t*)(Bop), (K_), E.hf, E.hb, E.ssq, E.xin ? a.in[1] : nullptr); } while (0)
    if (IN(0)) { phase_prologue(C); if (((REP_MASK >> 0) & 1)) { grid.sync(); phase_prologue(C); } }
    SEAM(0);
    if (IN(1)) { { EpiIn E{ssq, (bf16_t*)(ws + WS_ZB), (bf16_t*)(ws + WS_X1), (float*)(ws + WS_DT)}; GEMM(EpiIn, E, hb, ws + WS_WIN, NIN_PAD, DM); { int vi_, vn_; idle_vgrid(C, (M / 256) * (NIN_PAD / 256), vi_, vn_); convert_items(C, vi_, vn_, IT_UP0, IT_UP1); convert_items(C, vi_, vn_, IT_DN0, IT_DN1); } } if (((REP_MASK >> 1) & 1)) { grid.sync(); { EpiIn E{ssq, (bf16_t*)(ws + WS_ZB), (bf16_t*)(ws + WS_X1), (float*)(ws + WS_DT)}; GEMM(EpiIn, E, hb, ws + WS_WIN, NIN_PAD, DM); { int vi_, vn_; idle_vgrid(C, (M / 256) * (NIN_PAD / 256), vi_, vn_); convert_items(C, vi_, vn_, IT_UP0, IT_UP1); convert_items(C, vi_, vn_, IT_DN0, IT_DN1); } } } }
    SEAM(1);
    for (int i_ = 0; i_ < EXTRA_SYNCS; ++i_) xcd_barrier(bar);
    if (IN(2)) { phase_mconv(C); if (((REP_MASK >> 2) & 1)) { grid.sync(); phase_mconv(C); } }
    SEAM(2);
    if (IN(3)) { phase_ssd1(C, 0, NCH * 4); if (((REP_MASK >> 3) & 1)) { grid.sync(); phase_ssd1(C, 0, NCH * 4); } }
    SEAM(3);
    if (IN(4)) { phase_ssd1(C, NCH * 4, SSD_UNITS); phase_ssd3(C, NCH * 4, SSD_UNITS, C.G - (NSB * 4) % C.G); phase_scan(C); if (((REP_MASK >> 4) & 1)) { grid.sync(); phase_ssd1(C, NCH * 4, SSD_UNITS); phase_ssd3(C, NCH * 4, SSD_UNITS, C.G - (NSB * 4) % C.G); phase_scan(C); } }
    SEAM(4);
    if (IN(5)) { phase_ssd3(C, 0, NCH * 4, 0); if (((REP_MASK >> 5) & 1)) { grid.sync(); phase_ssd3(C, 0, NCH * 4, 0); } }
    SEAM(5);
    if (IN(6)) { { EpiRes E{a.out, hb, ssq + SSQN, a.in[0]}; GEMMR(E, ws + WS_X1, ws + WS_WOUT, DI); } if (((REP_MASK >> 6) & 1)) { grid.sync(); { EpiRes E{a.out, hb, ssq + SSQN, a.in[0]}; GEMMR(E, ws + WS_X1, ws + WS_WOUT, DI); } } }
    SEAM(6);
    if (IN(7)) { { EpiUp E2{ssq + SSQN + MP, (bf16_t*)(ws + WS_UPS)}; GEMMS(EpiUp, E2, hb + (size_t)MP * DM, ws + WS_WUP, NUP, DM); EpiUpF E{ssq + SSQN, (bf16_t*)(ws + WS_G), (float*)(ws + WS_EDGE), a.in[26], a.in[27]}; GEMMM(EpiUpF, E, hb, ws + WS_WUP, MP, NUP, DM); { const int ex_ = ((MP / 256) * (NUP / 256)) % C.G, sm_ = (MS / 256) * (NUP / 256); const int hi_ = C.G - sm_; const bool idle_ = ex_ > 0 && hi_ > ex_ && C.bid >= ex_ && C.bid < hi_; convert_items(C, idle_ ? C.bid - ex_ : (ex_ > 0 && hi_ > ex_ ? -1 : C.bid), ex_ > 0 && hi_ > ex_ ? hi_ - ex_ : C.G, IT_Q, IT_O); } } if (((REP_MASK >> 7) & 1)) { grid.sync(); { EpiUp E2{ssq + SSQN + MP, (bf16_t*)(ws + WS_UPS)}; GEMMS(EpiUp, E2, hb + (size_t)MP * DM, ws + WS_WUP, NUP, DM); EpiUpF E{ssq + SSQN, (bf16_t*)(ws + WS_G), (float*)(ws + WS_EDGE), a.in[26], a.in[27]}; GEMMM(EpiUpF, E, hb, ws + WS_WUP, MP, NUP, DM); { const int ex_ = ((MP / 256) * (NUP / 256)) % C.G, sm_ = (MS / 256) * (NUP / 256); const int hi_ = C.G - sm_; const bool idle_ = ex_ > 0 && hi_ > ex_ && C.bid >= ex_ && C.bid < hi_; convert_items(C, idle_ ? C.bid - ex_ : (ex_ > 0 && hi_ > ex_ ? -1 : C.bid), ex_ > 0 && hi_ > ex_ ? hi_ - ex_ : C.G, IT_Q, IT_O); } } } }
    SEAM(7);
    if (IN(8)) { phase_fconv(C, 0); if (((REP_MASK >> 8) & 1)) { grid.sync(); phase_fconv(C, 0); } }
    SEAM(8);
    if (IN(9)) { { EpiRes E{a.out, hb, ssq + 2 * SSQN, nullptr}; GEMMR(E, ws + WS_G, ws + WS_WDN, DFF); } if (((REP_MASK >> 9) & 1)) { grid.sync(); { EpiRes E{a.out, hb, ssq + 2 * SSQN, nullptr}; GEMMR(E, ws + WS_G, ws + WS_WDN, DFF); } } }
    SEAM(9);
    if (IN(10)) { { EpiQkv E{ssq + 2 * SSQN, (bf16_t*)(ws + WS_QB), (bf16_t*)(ws + WS_KB), (bf16_t*)(ws + WS_VB), a.out, C.in[22]}; GEMM(EpiQkv, E, hb, ws + WS_WQ, NQ, DM); { int vi_, vn_; idle_vgrid(C, (M / 256) * (NQ / 256), vi_, vn_); convert_items(C, vi_, vn_, IT_UP1, IT_DN0); convert_items(C, vi_, vn_, IT_DN1, IT_Q); convert_items(C, vi_, vn_, IT_O, IT_END); } } if (((REP_MASK >> 10) & 1)) { grid.sync(); { EpiQkv E{ssq + 2 * SSQN, (bf16_t*)(ws + WS_QB), (bf16_t*)(ws + WS_KB), (bf16_t*)(ws + WS_VB), a.out, C.in[22]}; GEMM(EpiQkv, E, hb, ws + WS_WQ, NQ, DM); { int vi_, vn_; idle_vgrid(C, (M / 256) * (NQ / 256), vi_, vn_); convert_items(C, vi_, vn_, IT_UP1, IT_DN0); convert_items(C, vi_, vn_, IT_DN1, IT_Q); convert_items(C, vi_, vn_, IT_O, IT_END); } } } }
    SEAM(10);
    if (IN(11)) { phase_cumsum(C); phase_norms(C); if (((REP_MASK >> 11) & 1)) { grid.sync(); phase_cumsum(C); phase_norms(C); } }
    SEAM(11);
    if (IN(12)) {
        const attn_body::AttnTensors AT{(const attn_body::bf16*)(ws + WS_QB), (const attn_body::bf16*)(ws + WS_KB), (const attn_body::bf16*)(ws + WS_VB), (attn_body::bf16*)(ws + WS_QB)};
        const attn_body::StaticOrder S((int)C.G, (int)C.bid);
        attn_body::attn_phase<attn_body::StaticOrder, ATTN_THRL>((char*)lds, AT, S, (const float*)(ws + WS_CB), (const float*)(ws + WS_NRM));
        __syncthreads();
#ifdef REP_ATTN
        { grid.sync(); const attn_body::AttnTensors AT2{(const attn_body::bf16*)(ws + WS_QB), (const attn_body::bf16*)(ws + WS_KB), (const attn_body::bf16*)(ws + WS_VB), (attn_body::bf16*)(ws + WS_G)};
          for (int rep_ = 0; rep_ < REP_ATTN; ++rep_) { attn_body::attn_phase<attn_body::StaticOrder, ATTN_THRL>((char*)lds, AT2, S, (const float*)(ws + WS_CB), (const float*)(ws + WS_NRM)); __syncthreads(); } }
#endif
        phase_attn_sample(C);
    }
    SEAM(12);
    if (IN(13)) { { EpiRes E{a.out, hb, ssq + 3 * SSQN, nullptr}; GEMMR(E, ws + WS_QB, ws + WS_WO, DM); } if (((REP_MASK >> 13) & 1)) { grid.sync(); { EpiRes E{a.out, hb, ssq + 3 * SSQN, nullptr}; GEMMR(E, ws + WS_QB, ws + WS_WO, DM); } } }
    SEAM(13);
    if (IN(14)) { { EpiUp E2{ssq + 3 * SSQN + MP, (bf16_t*)(ws + WS_UPS)}; GEMMS(EpiUp, E2, hb + (size_t)MP * DM, ws + WS_WUP + (size_t)NUP * DM * 2, NUP, DM); EpiUpF E{ssq + 3 * SSQN, (bf16_t*)(ws + WS_G), (float*)(ws + WS_EDGE), a.in[26] + 3 * NUP, a.in[27] + NUP}; GEMMM(EpiUpF, E, hb, ws + WS_WUP + (size_t)NUP * DM * 2, MP, NUP, DM); } if (((REP_MASK >> 14) & 1)) { grid.sync(); { EpiUp E2{ssq + 3 * SSQN + MP, (bf16_t*)(ws + WS_UPS)}; GEMMS(EpiUp, E2, hb + (size_t)MP * DM, ws + WS_WUP + (size_t)NUP * DM * 2, NUP, DM); EpiUpF E{ssq + 3 * SSQN, (bf16_t*)(ws + WS_G), (float*)(ws + WS_EDGE), a.in[26] + 3 * NUP, a.in[27] + NUP}; GEMMM(EpiUpF, E, hb, ws + WS_WUP + (size_t)NUP * DM * 2, MP, NUP, DM); } } }
    SEAM(14);
    if (IN(15)) { phase_fconv(C, 1); if (((REP_MASK >> 15) & 1)) { grid.sync(); phase_fconv(C, 1); } }
    SEAM(15);
    if (IN(16)) { { EpiRes E{a.out, hb, ssq, nullptr}; GEMMR(E, ws + WS_G, ws + WS_WDN + (size_t)DM * DFF * 2, DFF); } if (((REP_MASK >> 16) & 1)) { grid.sync(); { EpiRes E{a.out, hb, ssq, nullptr}; GEMMR(E, ws + WS_G, ws + WS_WDN + (size_t)DM * DFF * 2, DFF); } } }
    SEAM(16);
    if (IN(17)) { phase_final(C); if (((REP_MASK >> 17) & 1)) { grid.sync(); phase_final(C); } }
#undef IN
#undef SEAM
#undef GEMM
#undef GEMMM
#undef GEMMR
#undef GEMMS
}
constexpr int N_PHASES = 18;
#ifndef MK_SPLIT
#define MK_SPLIT 0
#endif
extern "C" void kernel_launch(void* const* d_in, const int* in_sizes, int n_in, void* d_out, int out_size, void* d_ws, size_t ws_size, hipStream_t stream) {
    static int grid = 0;
    if (grid == 0) {
        if (n_in != 30 || (size_t)out_size != O_END || ws_size < WS_NEED) { fprintf(stderr, "kernel_launch: unexpected sizes n_in %d out %d (want %zu) ws %zu (need %zu)\n", n_in, out_size, (size_t)O_END, ws_size, (size_t)WS_NEED); grid = -1; return; }
        int dev = 0, cus = 0, per_cu = 0;
        hipGetDevice(&dev); hipDeviceGetAttribute(&cus, hipDeviceAttributeMultiprocessorCount, dev);
        hipFuncSetAttribute((const void*)mega_fwd, hipFuncAttributeMaxDynamicSharedMemorySize, LDS_TOTAL);
        hipOccupancyMaxActiveBlocksPerMultiprocessor(&per_cu, (const void*)mega_fwd, NT_, LDS_TOTAL);
        if (per_cu < 1) { fprintf(stderr, "kernel_launch: occupancy query says %d blocks per CU\n", per_cu); per_cu = 1; }
        (void)hipGetLastError();
        grid = cus * 1;
    }
    if (grid < 0) return;
    Args a{};
    for (int i = 0; i < 30; ++i) a.in[i] = (const float*)d_in[i];
    a.out = (float*)d_out; a.ws = (unsigned char*)d_ws;
#if MK_SPLIT
    for (int p = 0; p < N_PHASES; ++p) { a.ph_lo = p; a.ph_hi = p + 1; hipLaunchKernelGGL(mega_fwd, dim3(grid), dim3(NT_), LDS_TOTAL, stream, a); }
#else
    a.ph_lo = 0; a.ph_hi = N_PHASES;
    void* args[] = {&a};
    hipError_t e = hipLaunchCooperativeKernel((const void*)mega_fwd, dim3(grid), dim3(NT_), args, LDS_TOTAL, stream);
    if (e != hipSuccess) fprintf(stderr, "cooperative launch failed: %s (grid %d)\n", hipGetErrorString(e), grid);
#endif
}
```
